# Optimizing an MI355X kernel written in HIP

```python
import jax, jax.numpy as jnp
from jax import lax
import numpy as np

D_MODEL = 1024
BATCH = 4
SEQ = 4096
DEPTH = 1

D_MIX = D_MODEL
RW_HEAD_DIM = 64
RW_WIDTH = D_MIX // 2
RW_HEADS = RW_WIDTH // RW_HEAD_DIM
HG_DK = 128
HG_WIDTH = D_MIX - RW_WIDTH
HG_HEADS = HG_WIDTH // HG_DK
HG_DV = HG_WIDTH // HG_HEADS
HG_KEY = HG_HEADS * HG_DK
DECAY_LORA = 64
ICL_LORA = 64
N_DIR = 2
HG_CHUNK = 64
NORM_EPS = 1e-6
GN_EPS = 64e-5
RW_SIZES = (RW_WIDTH, RW_WIDTH, RW_WIDTH, RW_WIDTH, DECAY_LORA, DECAY_LORA, ICL_LORA, ICL_LORA)
HG_SIZES = (HG_KEY, HG_KEY, HG_KEY, HG_WIDTH, HG_WIDTH)
RW_COLS = 4 * RW_WIDTH + N_DIR * (DECAY_LORA + ICL_LORA)
HG_COLS = 3 * HG_KEY + 2 * HG_WIDTH
IN_COLS = RW_COLS + HG_COLS

kernel_name = "hybrid_rwkv7_hgrn2_bidir_layer"


def rms_norm(x, g):
    xf = x.astype(jnp.float32)
    y = xf * lax.rsqrt(jnp.mean(xf * xf, axis=-1, keepdims=True) + NORM_EPS)
    return (y * g.astype(jnp.float32)).astype(x.dtype)


def split_cols(z, sizes):
    offs = np.cumsum(np.array(sizes))[:-1].tolist()
    return jnp.split(z, offs, axis=-1)


def centred_token_shift(p, mu_prev, mu_next):
    zeros = jnp.zeros_like(p[:, :1])
    p_prev = jnp.concatenate([zeros, p[:, :-1]], axis=1)
    p_next = jnp.concatenate([p[:, 1:], zeros], axis=1)
    return p + mu_prev * (p_prev - p) + mu_next * (p_next - p)


def orient(t2):
    return jnp.stack([t2[0], jnp.flip(t2[1], axis=1)], axis=0)


def merge_dirs(y2):
    return y2[0] + jnp.flip(y2[1], axis=1)


def rwkv7_scan(r, w, k, v, kk, b):
    def step(S, inp):
        r_t, w_t, k_t, v_t, kk_t, b_t = inp
        S = (S * w_t[..., None, :]
             - jnp.einsum('dbhij,dbhj->dbhi', S, kk_t)[..., None] * b_t[..., None, :]
             + v_t[..., :, None] * k_t[..., None, :])
        return S, jnp.einsum('dbhij,dbhj->dbhi', S, r_t)
    xs = [jnp.moveaxis(a, 2, 0) for a in (r, w, k, v, kk, b)]
    n_dir, bsz, _, heads, n = r.shape
    S0 = jnp.zeros((n_dir, bsz, heads, n, n), jnp.float32)
    _, y = lax.scan(step, S0, xs)
    return jnp.moveaxis(y, 0, 2)


def rwkv7_mixer(z, w0, w2, a0, a2, k_k, k_a, r_k, ln_w, ln_b):
    bsz, seq, _ = z.shape
    zf = z.astype(jnp.float32)
    r, k, v, g, wd_f, wd_b, ad_f, ad_b = split_cols(zf, RW_SIZES)
    heads = lambda t: t.reshape(t.shape[:-1] + (RW_HEADS, RW_HEAD_DIM))
    w_raw = w0[:, None, None, :] + jnp.einsum('dbtr,drc->dbtc', jnp.tanh(jnp.stack([wd_f, wd_b])), w2)
    w_log = -jax.nn.softplus(-w_raw) - 0.5
    decay = jnp.exp(-jnp.exp(w_log))
    a = jax.nn.sigmoid(a0[:, None, None, :] + jnp.einsum('dbtr,drc->dbtc', jnp.stack([ad_f, ad_b]), a2))
    kk = heads(k * k_k)
    kk = kk / jnp.maximum(jnp.linalg.norm(kk, axis=-1, keepdims=True), 1e-12)
    k_dir = heads(k[None] * (1.0 + (a - 1.0) * k_a))
    a_h = heads(a)
    r_h, v_h = heads(r), heads(v)
    y2 = rwkv7_scan(orient(jnp.stack([r_h, r_h])), orient(heads(decay)), orient(k_dir),
                    orient(jnp.stack([v_h, v_h])), orient(jnp.stack([kk, kk])),
                    orient(kk[None] * a_h))
    y = merge_dirs(y2)
    mu = jnp.mean(y, axis=-1, keepdims=True)
    var = jnp.mean(jnp.square(y - mu), axis=-1, keepdims=True)
    y = (y - mu) * lax.rsqrt(var + GN_EPS) * heads(ln_w) + heads(ln_b)
    bonus = jnp.sum(r_h[None] * k_dir * r_k, axis=(0, -1))[..., None] * v_h
    out = (y + bonus).reshape(bsz, seq, RW_WIDTH) * jax.nn.silu(g)
    return out.astype(z.dtype)


def hgrn2_chunked_scan(q, k, v, log_f):
    n_dir, bsz, seq, heads, dk = q.shape
    dv = v.shape[-1]
    n_chunks = seq // HG_CHUNK
    to_chunks = lambda t: t.reshape(n_dir, bsz, n_chunks, HG_CHUNK, heads, t.shape[-1]).transpose(2, 0, 1, 4, 3, 5)
    causal = jnp.tril(jnp.ones((HG_CHUNK, HG_CHUNK), bool))[:, :, None]

    def step(S, inp):
        q_c, k_c, v_c, g_c = inp
        b = jnp.cumsum(g_c, axis=-2)
        o_inter = jnp.einsum('dbhck,dbhkv->dbhcv', q_c * jnp.exp(b), S)
        diff = b[..., :, None, :] - b[..., None, :, :]
        dec = jnp.where(causal, jnp.exp(jnp.where(causal, diff, 0.0)), 0.0)
        scores = jnp.einsum('dbhtk,dbhtsk,dbhsk->dbhts', q_c, dec, k_c)
        o_intra = jnp.einsum('dbhts,dbhsv->dbhtv', scores, v_c)
        b_end = b[..., -1:, :]
        S = (jnp.exp(b_end[..., 0, :])[..., None] * S
             + jnp.einsum('dbhck,dbhcv->dbhkv', k_c * jnp.exp(b_end - b), v_c))
        return S, o_inter + o_intra

    S0 = jnp.zeros((n_dir, bsz, heads, dk, dv), jnp.float32)
    _, o = lax.scan(step, S0, [to_chunks(t) for t in (q, k, v, log_f)])
    return o.transpose(1, 2, 0, 4, 3, 5).reshape(n_dir, bsz, seq, heads, dv)


def hgrn2_mixer(z, lower_bound, norm_g):
    bsz, seq, _ = z.shape
    zf = z.astype(jnp.float32)
    q, f_f, f_b, i, g = split_cols(zf, HG_SIZES)
    kheads = lambda t: t.reshape(t.shape[:-1] + (HG_HEADS, HG_DK))
    vheads = lambda t: t.reshape(t.shape[:-1] + (HG_HEADS, HG_DV))
    f = lower_bound + (1.0 - lower_bound) * jax.nn.sigmoid(jnp.stack([f_f, f_b]))
    q_h, i_h = kheads(q), vheads(i)
    o2 = hgrn2_chunked_scan(orient(jnp.stack([q_h, q_h])), orient(kheads(1.0 - f)),
                            orient(jnp.stack([i_h, i_h])), orient(kheads(jnp.log(f))))
    o = merge_dirs(o2)
    o = o * lax.rsqrt(jnp.mean(o * o, axis=-1, keepdims=True) + NORM_EPS) * norm_g
    out = o.reshape(bsz, seq, HG_WIDTH) * jax.nn.silu(g)
    return out.astype(z.dtype)


def setup_inputs(seed: int = 0) -> dict:
    key = jax.random.key(seed)
    ks = jax.random.split(key, 20)
    nrm = lambda k, shape: jax.random.normal(k, shape, jnp.float32)
    L = DEPTH
    w0_base = jnp.linspace(-6.0, -1.0, RW_WIDTH, dtype=jnp.float32)
    return {
        "x": nrm(ks[0], (BATCH, SEQ, D_MODEL)),
        "pre_norm_g": 1.0 + 0.02 * nrm(ks[1], (L, D_MODEL)),
        "w_in": nrm(ks[2], (L, D_MODEL, IN_COLS)) * D_MODEL ** -0.5,
        "rw_shift_prev": jax.random.uniform(ks[3], (L, RW_COLS), jnp.float32, 0.0, 0.5),
        "rw_shift_next": jax.random.uniform(ks[4], (L, RW_COLS), jnp.float32, 0.0, 0.5),
        "rw_w0": w0_base + 0.1 * nrm(ks[5], (L, N_DIR, RW_WIDTH)),
        "rw_w2": 0.1 * nrm(ks[6], (L, N_DIR, DECAY_LORA, RW_WIDTH)) * DECAY_LORA ** -0.5,
        "rw_a0": 0.1 * nrm(ks[7], (L, N_DIR, RW_WIDTH)),
        "rw_a2": 0.1 * nrm(ks[8], (L, N_DIR, ICL_LORA, RW_WIDTH)) * ICL_LORA ** -0.5,
        "rw_k_k": 0.85 + 0.02 * nrm(ks[9], (L, RW_WIDTH)),
        "rw_k_a": 1.0 + 0.02 * nrm(ks[10], (L, RW_WIDTH)),
        "rw_r_k": -0.04 + 0.02 * nrm(ks[11], (L, RW_HEADS, RW_HEAD_DIM)),
        "rw_ln_w": 1.0 + 0.02 * nrm(ks[12], (L, RW_WIDTH)),
        "rw_ln_b": 0.02 * nrm(ks[13], (L, RW_WIDTH)),
        "hg_lb_logits": 0.5 * nrm(ks[14], (DEPTH + 1, HG_KEY)),
        "hg_norm_g": 1.0 + 0.02 * nrm(ks[15], (L, HG_DV)),
        "w_out": nrm(ks[16], (L, D_MIX, D_MODEL)) * D_MIX ** -0.5,
        "post_norm_g": 1.0 + 0.02 * nrm(ks[17], (L, D_MODEL)),
    }


def reference(x, pre_norm_g, w_in, rw_shift_prev, rw_shift_next, rw_w0, rw_w2, rw_a0, rw_a2,
              rw_k_k, rw_k_a, rw_r_k, rw_ln_w, rw_ln_b, hg_lb_logits, hg_norm_g, w_out, post_norm_g):
    lower_bounds = jnp.cumsum(jax.nn.softmax(hg_lb_logits.astype(jnp.float32), axis=0), axis=0)
    for l in range(DEPTH):
        h = rms_norm(x, pre_norm_g[l])
        p = h @ w_in[l]
        rw_in = centred_token_shift(p[..., :RW_COLS], rw_shift_prev[l], rw_shift_next[l])
        y_rw = rwkv7_mixer(rw_in, rw_w0[l], rw_w2[l], rw_a0[l], rw_a2[l], rw_k_k[l], rw_k_a[l],
                           rw_r_k[l], rw_ln_w[l], rw_ln_b[l])
        y_hg = hgrn2_mixer(p[..., RW_COLS:], lower_bounds[l], hg_norm_g[l])
        y = jnp.concatenate([y_rw, y_hg], axis=-1) @ w_out[l]
        x = x + rms_norm(y, post_norm_g[l])
    return x
```

```cpp
#include <hip/hip_runtime.h>
#include <stdint.h>

#define D_MODEL 1024
#define BATCH 4
#define SEQ 4096
#define MTOK (BATCH * SEQ)
#define RW_W 512
#define RW_COLS 2304
#define HG_COLS 2560
#define IN_COLS 4864

typedef unsigned short bf16_t;
__device__ __forceinline__ float bf2f(bf16_t b) { return __uint_as_float(((unsigned)b) << 16); }
__device__ __forceinline__ bf16_t f2bf(float f) { unsigned u = __float_as_uint(f); u += 0x7fffu + ((u >> 16) & 1u); return (bf16_t)(u >> 16); }

__device__ __forceinline__ float wave_sum(float v) {
#pragma unroll
    for (int o = 1; o < 64; o <<= 1) v += __shfl_xor(v, o);
    return v;
}

__global__ void __launch_bounds__(256) k_xn(const float* __restrict__ x, const float* __restrict__ g, bf16_t* __restrict__ xn) {
    const int wave = threadIdx.x >> 6, lane = threadIdx.x & 63;
    const int row = blockIdx.x * 4 + wave;
    const float* xr = x + (size_t)row * D_MODEL;
    float v[16]; float s = 0.f;
#pragma unroll
    for (int i = 0; i < 16; ++i) { v[i] = xr[lane + 64 * i]; s += v[i] * v[i]; }
    s = wave_sum(s);
    const float rstd = rsqrtf(s * (1.0f / D_MODEL) + 1e-6f);
#pragma unroll
    for (int i = 0; i < 16; ++i) xn[(size_t)row * D_MODEL + lane + 64 * i] = f2bf(v[i] * rstd * g[lane + 64 * i]);
}

template <bool OUT_BF16>
__global__ void __launch_bounds__(256) k_gemm(const bf16_t* __restrict__ A, const float* __restrict__ B, void* __restrict__ Cv, int M, int N, int K) {
    __shared__ float As[16][64 + 1];
    __shared__ float Bs[16][64 + 1];
    const int tx = threadIdx.x & 15, ty = threadIdx.x >> 4;
    const int m0 = blockIdx.y * 64, n0 = blockIdx.x * 64;
    float acc[4][4];
#pragma unroll
    for (int i = 0; i < 4; ++i)
#pragma unroll
        for (int j = 0; j < 4; ++j) acc[i][j] = 0.f;
    for (int k0 = 0; k0 < K; k0 += 16) {
        {
            const int r = threadIdx.x >> 2, kk = (threadIdx.x & 3) * 4;
            const bf16_t* ap = A + (size_t)(m0 + r) * K + k0 + kk;
#pragma unroll
            for (int i = 0; i < 4; ++i) As[kk + i][r] = bf2f(ap[i]);
        }
        {
            const int kk = threadIdx.x >> 4, c = (threadIdx.x & 15) * 4;
            const float* bp = B + (size_t)(k0 + kk) * N + n0 + c;
#pragma unroll
            for (int i = 0; i < 4; ++i) Bs[kk][c + i] = bp[i];
        }
        __syncthreads();
#pragma unroll
        for (int kk = 0; kk < 16; ++kk) {
            float a[4], b[4];
#pragma unroll
            for (int i = 0; i < 4; ++i) { a[i] = As[kk][ty * 4 + i]; b[i] = Bs[kk][tx * 4 + i]; }
#pragma unroll
            for (int i = 0; i < 4; ++i)
#pragma unroll
                for (int j = 0; j < 4; ++j) acc[i][j] += a[i] * b[j];
        }
        __syncthreads();
    }
#pragma unroll
    for (int i = 0; i < 4; ++i)
#pragma unroll
        for (int j = 0; j < 4; ++j) {
            const size_t o = (size_t)(m0 + ty * 4 + i) * N + n0 + tx * 4 + j;
            if (OUT_BF16) ((bf16_t*)Cv)[o] = f2bf(acc[i][j]); else ((float*)Cv)[o] = acc[i][j];
        }
}

__device__ __forceinline__ float shifted(const bf16_t* __restrict__ p, int b, int t, int c, float mup, float mun) {
    const size_t row = (size_t)b * SEQ + t;
    const float cur = bf2f(p[row * IN_COLS + c]);
    const float prv = t > 0 ? bf2f(p[(row - 1) * IN_COLS + c]) : 0.f;
    const float nxt = t < SEQ - 1 ? bf2f(p[(row + 1) * IN_COLS + c]) : 0.f;
    return cur + mup * (prv - cur) + mun * (nxt - cur);
}

__global__ void __launch_bounds__(64) k_rw_scan(const bf16_t* __restrict__ p, const float* __restrict__ mu_prev, const float* __restrict__ mu_next,
                                                const float* __restrict__ w0, const float* __restrict__ w2, const float* __restrict__ a0, const float* __restrict__ a2,
                                                const float* __restrict__ k_k, const float* __restrict__ k_a, const float* __restrict__ r_k,
                                                float* __restrict__ y_out, float* __restrict__ bonus) {
    __shared__ float lo[2][64];
    __shared__ float vec[5][64];
    const int lane = threadIdx.x;
    const int h = blockIdx.x & 7, b = (blockIdx.x >> 3) & 3, d = blockIdx.x >> 5;
    const int c = h * 64 + lane;
    const float mp_r = mu_prev[c], mn_r = mu_next[c], mp_k = mu_prev[512 + c], mn_k = mu_next[512 + c], mp_v = mu_prev[1024 + c], mn_v = mu_next[1024 + c];
    const int cw = 2048 + d * 64 + lane, ca = 2176 + d * 64 + lane;
    const float mp_w = mu_prev[cw], mn_w = mu_next[cw], mp_a = mu_prev[ca], mn_a = mu_next[ca];
    const float w0c = w0[d * 512 + c], a0c = a0[d * 512 + c], kkc = k_k[c], kac = k_a[c], rkc = r_k[c];
    const float* w2p = w2 + (size_t)d * 64 * 512 + c;
    const float* a2p = a2 + (size_t)d * 64 * 512 + c;
    float S[64];
#pragma unroll
    for (int j = 0; j < 64; ++j) S[j] = 0.f;
    for (int s = 0; s < SEQ; ++s) {
        const int t = d ? (SEQ - 1 - s) : s;
        const float rs = shifted(p, b, t, c, mp_r, mn_r);
        const float ks = shifted(p, b, t, 512 + c, mp_k, mn_k);
        const float vs = shifted(p, b, t, 1024 + c, mp_v, mn_v);
        const float wd = shifted(p, b, t, cw, mp_w, mn_w);
        const float ad = shifted(p, b, t, ca, mp_a, mn_a);
        __syncthreads();
        lo[0][lane] = tanhf(wd); lo[1][lane] = ad;
        __syncthreads();
        float wr = w0c, ar = a0c;
        for (int r = 0; r < 64; ++r) { wr += lo[0][r] * w2p[(size_t)r * 512]; ar += lo[1][r] * a2p[(size_t)r * 512]; }
        const float sp = (-wr > 20.f) ? -wr : log1pf(expf(-wr));
        const float wlog = -sp - 0.5f;
        const float decay = expf(-expf(wlog));
        const float a = 1.0f / (1.0f + expf(-ar));
        float kkv = ks * kkc;
        const float nrm = sqrtf(wave_sum(kkv * kkv));
        kkv = kkv / fmaxf(nrm, 1e-12f);
        const float kd = ks * (1.0f + (a - 1.0f) * kac);
        const float bb = kkv * a;
        const float bo = wave_sum(rs * kd * rkc);
        if (lane == 0) bonus[((size_t)d * MTOK + (size_t)b * SEQ + t) * 8 + h] = bo;
        vec[0][lane] = decay; vec[1][lane] = kd; vec[2][lane] = kkv; vec[3][lane] = bb; vec[4][lane] = rs;
        __syncthreads();
        float sa = 0.f;
#pragma unroll
        for (int j = 0; j < 64; ++j) sa += S[j] * vec[2][j];
        float y = 0.f;
#pragma unroll
        for (int j = 0; j < 64; ++j) { S[j] = S[j] * vec[0][j] - sa * vec[3][j] + vs * vec[1][j]; y += S[j] * vec[4][j]; }
        y_out[((size_t)d * MTOK + (size_t)b * SEQ + t) * 512 + c] = y;
    }
}

__global__ void __launch_bounds__(128) k_hg_scan(const bf16_t* __restrict__ p, const float* __restrict__ lb_logits, float* __restrict__ o_out) {
    __shared__ float fq[2][128];
    const int tid = threadIdx.x;
    const int h = blockIdx.x & 3, b = (blockIdx.x >> 2) & 3, d = blockIdx.x >> 4;
    const int c = h * 128 + tid;
    const float lb = 1.0f / (1.0f + expf(-(lb_logits[c] - lb_logits[512 + c])));
    float S[128];
#pragma unroll
    for (int j = 0; j < 128; ++j) S[j] = 0.f;
    for (int s = 0; s < SEQ; ++s) {
        const int t = d ? (SEQ - 1 - s) : s;
        const size_t row = (size_t)b * SEQ + t;
        const bf16_t* pr = p + row * IN_COLS + RW_COLS;
        const float q = bf2f(pr[c]);
        const float z = bf2f(pr[512 + d * 512 + c]);
        const float iv = bf2f(pr[1536 + c]);
        const float f = lb + (1.0f - lb) / (1.0f + expf(-z));
        __syncthreads();
        fq[0][tid] = f; fq[1][tid] = q;
        __syncthreads();
        float o = 0.f;
#pragma unroll
        for (int k = 0; k < 128; ++k) { const float fk = fq[0][k]; S[k] = fk * S[k] + (1.0f - fk) * iv; o += fq[1][k] * S[k]; }
        o_out[((size_t)d * MTOK + row) * 512 + c] = o;
    }
}

__global__ void __launch_bounds__(512) k_mix(const bf16_t* __restrict__ p, const float* __restrict__ mu_prev, const float* __restrict__ mu_next,
                                             const float* __restrict__ y_rw, const float* __restrict__ bonus, const float* __restrict__ ln_w, const float* __restrict__ ln_b,
                                             const float* __restrict__ o_hg, const float* __restrict__ norm_g, bf16_t* __restrict__ ymix) {
    __shared__ float red[8];
    const int tid = threadIdx.x, lane = tid & 63, wv = tid >> 6;
    const int row = blockIdx.x, b = row / SEQ, t = row % SEQ;
    {
        const int c = tid;
        const float y = y_rw[(size_t)row * 512 + c] + y_rw[((size_t)MTOK + row) * 512 + c];
        const float mu = wave_sum(y) * (1.0f / 64.0f);
        const float dlt = y - mu;
        const float var = wave_sum(dlt * dlt) * (1.0f / 64.0f);
        float yn = dlt * rsqrtf(var + 64e-5f) * ln_w[c] + ln_b[c];
        const float vs = shifted(p, b, t, 1024 + c, mu_prev[1024 + c], mu_next[1024 + c]);
        const float gs = shifted(p, b, t, 1536 + c, mu_prev[1536 + c], mu_next[1536 + c]);
        const float bo = bonus[(size_t)row * 8 + wv] + bonus[((size_t)MTOK + row) * 8 + wv];
        yn += bo * vs;
        const float out = yn * (gs / (1.0f + expf(-gs)));
        ymix[(size_t)row * 1024 + c] = f2bf(out);
    }
    {
        const int c = tid;
        const float o = o_hg[(size_t)row * 512 + c] + o_hg[((size_t)MTOK + row) * 512 + c];
        const float ss = wave_sum(o * o);
        if (lane == 0) red[wv] = ss;
        __syncthreads();
        const float tot = red[(wv & ~1)] + red[(wv | 1)];
        const float on = o * rsqrtf(tot * (1.0f / 128.0f) + 1e-6f) * norm_g[c & 127];
        const float g = bf2f(p[(size_t)row * IN_COLS + RW_COLS + 2048 + c]);
        ymix[(size_t)row * 1024 + 512 + c] = f2bf(on * (g / (1.0f + expf(-g))));
    }
}

__global__ void __launch_bounds__(256) k_post(const float* __restrict__ x, const float* __restrict__ y, const float* __restrict__ g, float* __restrict__ out) {
    const int wave = threadIdx.x >> 6, lane = threadIdx.x & 63;
    const int row = blockIdx.x * 4 + wave;
    const float* yr = y + (size_t)row * D_MODEL;
    float v[16]; float s = 0.f;
#pragma unroll
    for (int i = 0; i < 16; ++i) { v[i] = yr[lane + 64 * i]; s += v[i] * v[i]; }
    s = wave_sum(s);
    const float rstd = rsqrtf(s * (1.0f / D_MODEL) + 1e-6f);
#pragma unroll
    for (int i = 0; i < 16; ++i) { const size_t o = (size_t)row * D_MODEL + lane + 64 * i; out[o] = x[o] + v[i] * rstd * g[lane + 64 * i]; }
}

extern "C" void kernel_launch(void* const* d_in, const int* in_sizes, int n_in, void* d_out, int out_size, void* d_ws, size_t ws_size, hipStream_t stream) {
    const float* x = (const float*)d_in[0];
    const float* pre_g = (const float*)d_in[1];
    const float* w_in = (const float*)d_in[2];
    const float* mu_prev = (const float*)d_in[3];
    const float* mu_next = (const float*)d_in[4];
    const float* w0 = (const float*)d_in[5];
    const float* w2 = (const float*)d_in[6];
    const float* a0 = (const float*)d_in[7];
    const float* a2 = (const float*)d_in[8];
    const float* k_k = (const float*)d_in[9];
    const float* k_a = (const float*)d_in[10];
    const float* r_k = (const float*)d_in[11];
    const float* ln_w = (const float*)d_in[12];
    const float* ln_b = (const float*)d_in[13];
    const float* lb_logits = (const float*)d_in[14];
    const float* norm_g = (const float*)d_in[15];
    const float* w_out = (const float*)d_in[16];
    const float* post_g = (const float*)d_in[17];
    float* out = (float*)d_out;
    unsigned char* ws = (unsigned char*)d_ws;
    const size_t MiB = 1u << 20;
    bf16_t* P = (bf16_t*)(ws + 1 * MiB);
    float* YRW = (float*)(ws + 153 * MiB);
    bf16_t* XN = (bf16_t*)(ws + 217 * MiB);
    float* BON = (float*)(ws + 249 * MiB);
    float* OHG = (float*)d_out;
    bf16_t* YMIX = XN;
    float* Y = YRW;

    k_xn<<<MTOK / 4, 256, 0, stream>>>(x, pre_g, XN);
    k_gemm<true><<<dim3(IN_COLS / 64, MTOK / 64), 256, 0, stream>>>(XN, w_in, P, MTOK, IN_COLS, D_MODEL);
    k_rw_scan<<<64, 64, 0, stream>>>(P, mu_prev, mu_next, w0, w2, a0, a2, k_k, k_a, r_k, YRW, BON);
    k_hg_scan<<<32, 128, 0, stream>>>(P, lb_logits, OHG);
    k_mix<<<MTOK, 512, 0, stream>>>(P, mu_prev, mu_next, YRW, BON, ln_w, ln_b, OHG, norm_g, YMIX);
    k_gemm<false><<<dim3(D_MODEL / 64, MTOK / 64), 256, 0, stream>>>(YMIX, w_out, Y, MTOK, D_MODEL, D_MODEL);
    k_post<<<MTOK / 4, 256, 0, stream>>>(x, Y, post_g, out);
}
```

```cpp
#include <hip/hip_runtime.h>
#include <cstdio>
#include <cstdint>
namespace pg8 {
#define PG8_LAS __attribute__((address_space(3)))
typedef unsigned short bf16_t;
typedef short bf16x8 __attribute__((ext_vector_type(8)));
typedef float f32x4 __attribute__((ext_vector_type(4)));
typedef unsigned u32x4 __attribute__((ext_vector_type(4)));
constexpr int BM = 256, BK = 64, HALF = 128, HTB = HALF * BK * 2  , STAGE_BYTES = 8 * HTB, NXCD = 8, WGM = 8;

__host__ __device__ __forceinline__ int lds_byte(int r, int c) { const int st = (r >> 4) * 2 + (c >> 5), rr = r & 15, cc = c & 31, ob = rr * 64 + cc * 2; return st * 1024 + (ob ^ (((ob >> 9) & 1) << 5)); }
__host__ __device__ __forceinline__ void stage_rc(int b, int& R, int& C) { const int st = b / 1024, sb = b % 1024, swz = sb ^ (((sb >> 9) & 1) << 5); R = (st >> 1) * 16 + swz / 64; C = (st & 1) * 32 + (swz % 64) / 2; }
__host__ __device__ __forceinline__ int perm32(int rho) { const int n = rho >> 4, i = rho & 15; return 8 * (i >> 2) + 4 * n + (i & 3); }

struct Unit { int pm, pn; };
struct Gemm { const bf16_t* A; const bf16_t* Bt; int M, N, K; };

struct StaticOrder {
    int nM, nN, nwg, G, c;
    __host__ __device__ void init(int M, int N, int G_, int c_) { nM = M / BM; nN = N / BM; nwg = nM * nN; G = G_; c = c_; }
    __host__ __device__ bool next(int i, Unit& u) const {
        const long L = (long)i * G + c; if (L >= nwg) return false;
        int wgid = (int)L; { const int q = nwg / NXCD, r = nwg % NXCD, xcd = wgid % NXCD, off = wgid / NXCD; wgid = (xcd < r ? xcd * (q + 1) : r * (q + 1) + (xcd - r) * q) + off; }
        const int nig = WGM * nN, gid = wgid / nig, fm = gid * WGM, gsz = (nM - fm) < WGM ? (nM - fm) : WGM;
        u.pm = fm + ((wgid % nig) % gsz); u.pn = (wgid % nig) / gsz; return true;
    }
    __device__ __forceinline__ void a_ready(const Unit&) const {}
    __device__ __forceinline__ void done(const Unit&) const {}
};

__device__ __forceinline__ unsigned cvt_pk_bf16(float lo, float hi) { unsigned r; asm volatile("v_cvt_pk_bf16_f32 %0, %1, %2" : "=v"(r) : "v"(lo), "v"(hi)); return r; }
typedef float f32x2 __attribute__((ext_vector_type(2)));
__device__ __forceinline__ f32x2 gelu_pk(f32x2 v) {
    const f32x2 av = __builtin_elementwise_abs(v), d = av * 0.2316418882f + 1.0f;
    f32x2 t; t.x = __builtin_amdgcn_rcpf(d.x); t.y = __builtin_amdgcn_rcpf(d.y);
    f32x2 q = t * 0.5307027145f + (-0.7265760135f); q = q * t + 0.7107068705f; q = q * t + (-0.142248368f); q = q * t + 0.127414796f; q = q * t;
    const f32x2 s = (v * v) * (-0.72134752044f);
    f32x2 e; e.x = __builtin_amdgcn_exp2f(s.x); e.y = __builtin_amdgcn_exp2f(s.y);
    const f32x2 m = v * (q * e), r = v - m;
    f32x2 o; o.x = v.x < 0.f ? m.x : r.x; o.y = v.y < 0.f ? m.y : r.y; return o;
}

template <int ACT  > struct EpiBf16 {
    static constexpr bool PERM = true, AFTER_DRAIN = false; static_assert(ACT == 0 || ACT == 1, "EpiBf16: ACT is 0 (none) or 1 (gelu_pk)");
    bf16_t* O; int ldc; const float* bias; int split_cols; size_t split_stride; float scale0;
    __device__ __forceinline__ void operator()(const f32x4 (&acc)[2][2][4][2], const Unit& u, int wr, int wc, int fr, int fq) const {
        const int row0 = u.pm * BM + wr * 64 + fr; int colt = u.pn * BM; bf16_t* base = O;
        float sc = 1.f; if (split_cols) { const int t = colt / split_cols; base += (size_t)t * split_stride; colt -= t * split_cols; if (t == 0) sc = scale0; }
        const int col0 = colt + wc * 32 + 8 * fq, bcol0 = u.pn * BM + wc * 32 + 8 * fq;
        f32x4 bv[2][2];
#pragma unroll
        for (int bj = 0; bj < 2; ++bj)
#pragma unroll
            for (int n = 0; n < 2; ++n) bv[bj][n] = bias ? *(const f32x4*)(bias + bcol0 + bj * HALF + 4 * n) : (f32x4){0.f, 0.f, 0.f, 0.f};
#pragma unroll
        for (int ai = 0; ai < 2; ++ai)
#pragma unroll
            for (int m = 0; m < 4; ++m) { bf16_t* rowp = base + (size_t)(row0 + ai * HALF + m * 16) * ldc + col0;
#pragma unroll
                for (int bj = 0; bj < 2; ++bj) { f32x4 v0 = acc[ai][bj][m][0] + bv[bj][0], v1 = acc[ai][bj][m][1] + bv[bj][1];
                    if (ACT == 1) { f32x2 a = gelu_pk((f32x2){v0[0], v0[1]}), b = gelu_pk((f32x2){v0[2], v0[3]}), c = gelu_pk((f32x2){v1[0], v1[1]}), d = gelu_pk((f32x2){v1[2], v1[3]});
                        v0 = (f32x4){a.x, a.y, b.x, b.y}; v1 = (f32x4){c.x, c.y, d.x, d.y}; }
                    v0 = v0 * sc; v1 = v1 * sc; u32x4 w; w.x = cvt_pk_bf16(v0[0], v0[1]); w.y = cvt_pk_bf16(v0[2], v0[3]); w.z = cvt_pk_bf16(v1[0], v1[1]); w.w = cvt_pk_bf16(v1[2], v1[3]);
                    *(u32x4*)(rowp + bj * HALF) = w; } }
    }
};
struct EpiF32 {
    static constexpr bool PERM = false, AFTER_DRAIN = false;
    float* C; int ldc; const float* bias;
    __device__ __forceinline__ void operator()(const f32x4 (&acc)[2][2][4][2], const Unit& u, int wr, int wc, int fr, int fq) const {
        const int row0 = u.pm * BM + wr * 64 + fr, col0 = u.pn * BM + wc * 32 + 4 * fq;
        f32x4 bv[2][2];
#pragma unroll
        for (int bj = 0; bj < 2; ++bj)
#pragma unroll
            for (int n = 0; n < 2; ++n) bv[bj][n] = bias ? *(const f32x4*)(bias + col0 + bj * HALF + n * 16) : (f32x4){0.f, 0.f, 0.f, 0.f};
#pragma unroll
        for (int ai = 0; ai < 2; ++ai)
#pragma unroll
            for (int m = 0; m < 4; ++m) { float* rowp = C + (size_t)(row0 + ai * HALF + m * 16) * ldc + col0;
#pragma unroll
                for (int bj = 0; bj < 2; ++bj)
#pragma unroll
                    for (int n = 0; n < 2; ++n) *(f32x4*)(rowp + bj * HALF + n * 16) = acc[ai][bj][m][n] + bv[bj][n]; }
    }
};
template <class Epi, class Sched, bool ALIGN_EPI = false, bool SP2 = false>
__device__ __forceinline__ void gemm_phase(PG8_LAS unsigned char* lds, const Gemm g, const Sched& S, const Epi& E) {
    const int tid = threadIdx.x, wid = __builtin_amdgcn_readfirstlane(tid >> 6), lane = tid & 63, wr = wid >> 2, wc = wid & 3, fr = lane & 15, fq = lane >> 4;
    const int K = g.K, nt = K / BK;
    unsigned voffA[2], voffB[2];
#pragma unroll
    for (int i = 0; i < 2; ++i) { int R, C; stage_rc(tid * 16 + i * 8192, R, C); const int Rb = Epi::PERM ? ((R & ~31) + perm32(R & 31)) : R;
        voffA[i] = (unsigned)(R * K + C) * 2u; voffB[i] = (unsigned)(Rb * K + C) * 2u; }
    const size_t kstep = (size_t)(BK * 2);
    const size_t hstep = (size_t)HALF * K * 2;
    const size_t tstep = 2 * hstep;
    const unsigned ldsw = (unsigned)wid * 1024u;
    const int aoff = lds_byte(wr * 64 + fr, fq * 8), boff = lds_byte(wc * 32 + fr, fq * 8);
#define PG8_SA(b, h) (((b) * 2 + (h)) * HTB)
#define PG8_SB(b, h) ((4 + (b) * 2 + (h)) * HTB)
#define PG8_STAGE(bufoff, gbase, voff) do { _Pragma("unroll") for (int _i = 0; _i < 2; ++_i) \
        __builtin_amdgcn_global_load_lds((const unsigned*)((const char*)(gbase) + (voff)[_i]), (PG8_LAS unsigned*)(lds + (bufoff) + ldsw + _i * 8192), 16, 0, 0); } while (0)
#define PG8_LDA(dst, b, h) do { _Pragma("unroll") for (int m = 0; m < 4; ++m) _Pragma("unroll") for (int k = 0; k < 2; ++k) dst[m][k] = *(const PG8_LAS bf16x8*)(lds + PG8_SA(b, h) + aoff + m * 2048 + k * 1024); } while (0)
#define PG8_LDB(dst, b, h) do { _Pragma("unroll") for (int n = 0; n < 2; ++n) _Pragma("unroll") for (int k = 0; k < 2; ++k) dst[n][k] = *(const PG8_LAS bf16x8*)(lds + PG8_SB(b, h) + boff + n * 2048 + k * 1024); } while (0)
#define PG8_MMA(ai, bj, At, Bt) do { __builtin_amdgcn_s_setprio(1); _Pragma("unroll") for (int m = 0; m < 4; ++m) _Pragma("unroll") for (int n = 0; n < 2; ++n) _Pragma("unroll") for (int k = 0; k < 2; ++k) \
        acc[ai][bj][m][n] = __builtin_amdgcn_mfma_f32_16x16x32_bf16(Bt[n][k], At[m][k], acc[ai][bj][m][n], 0, 0, 0); __builtin_amdgcn_s_setprio(0); } while (0)
#define PG8_WAIT_V(n) asm volatile("s_waitcnt vmcnt(" #n ")" ::: "memory")
#define PG8_WAIT_L(n) asm volatile("s_waitcnt lgkmcnt(" #n ")" ::: "memory")
#define PG8_BAR __builtin_amdgcn_s_barrier()
#define PG8_SCHED __builtin_amdgcn_sched_barrier(0)
    Unit cur, nxt; int ui = 0;
    if (!S.next(0, cur)) return;
    f32x4 acc[2][2][4][2];
#pragma unroll
    for (int a = 0; a < 2; ++a)
#pragma unroll
        for (int b = 0; b < 2; ++b)
#pragma unroll
            for (int m = 0; m < 4; ++m)
#pragma unroll
                for (int n = 0; n < 2; ++n) acc[a][b][m][n] = (f32x4){0.f, 0.f, 0.f, 0.f};
    bf16x8 At[4][2], B0[2][2], B1[2][2];
    const char* cA = (const char*)g.A + (size_t)cur.pm * tstep; const char* cB = (const char*)g.Bt + (size_t)cur.pn * tstep;
    S.a_ready(cur);
    if constexpr (SP2) {
        PG8_STAGE(PG8_SB(0, 0), cB, voffB); PG8_STAGE(PG8_SB(0, 1), cB + hstep, voffB); PG8_STAGE(PG8_SA(0, 0), cA, voffA); PG8_STAGE(PG8_SA(0, 1), cA + hstep, voffA);
        if (wr == 1) PG8_BAR;
        PG8_WAIT_V(2); PG8_BAR;
        PG8_STAGE(PG8_SB(1, 0), cB + kstep, voffB); PG8_STAGE(PG8_SA(1, 0), cA + kstep, voffA); PG8_STAGE(PG8_SB(1, 1), cB + hstep + kstep, voffB);
        PG8_WAIT_V(6); PG8_BAR;
    } else {
        PG8_STAGE(PG8_SB(0, 0), cB, voffB); PG8_STAGE(PG8_SA(0, 0), cA, voffA); PG8_STAGE(PG8_SB(0, 1), cB + hstep, voffB); PG8_STAGE(PG8_SA(0, 1), cA + hstep, voffA);
        if (wr == 1) PG8_BAR;
        PG8_WAIT_V(4); PG8_BAR;
        PG8_STAGE(PG8_SB(1, 0), cB + kstep, voffB); PG8_STAGE(PG8_SA(1, 0), cA + kstep, voffA); PG8_STAGE(PG8_SB(1, 1), cB + hstep + kstep, voffB);
        PG8_WAIT_V(6); PG8_BAR;
    }
    for (;;) {
        const bool has_next = S.next(ui + 1, nxt);
        const char* nA = has_next ? (const char*)g.A + (size_t)nxt.pm * tstep : cA; const char* nB = has_next ? (const char*)g.Bt + (size_t)nxt.pn * tstep : cB;
        for (int t = 0; t < nt; t += 2) {
            const bool last = (t == nt - 2);
            const char* a1 = cA + (size_t)(t + 1) * kstep;
            const char* a2 = last ? nA : cA + (size_t)(t + 2) * kstep; const char* b2 = last ? nB : cB + (size_t)(t + 2) * kstep;
            const char* a3 = a2 + kstep; const char* b3 = b2 + kstep;
            if (last && has_next) S.a_ready(nxt);
            if constexpr (SP2) {
            PG8_LDB(B0, 0, 0); PG8_LDB(B1, 0, 1); PG8_SCHED; PG8_LDA(At, 0, 0); PG8_STAGE(PG8_SA(1, 1), a1 + hstep, voffA);
            PG8_WAIT_V(8); PG8_WAIT_L(0); PG8_BAR; PG8_MMA(0, 0, At, B0); PG8_MMA(0, 1, At, B1); PG8_BAR; PG8_SCHED;
            PG8_LDA(At, 0, 1); PG8_STAGE(PG8_SB(0, 0), b2, voffB); PG8_STAGE(PG8_SB(0, 1), b2 + hstep, voffB); PG8_STAGE(PG8_SA(0, 0), a2, voffA);
            PG8_WAIT_V(8); PG8_WAIT_L(0); PG8_BAR; PG8_MMA(1, 0, At, B0); PG8_MMA(1, 1, At, B1); PG8_BAR; PG8_SCHED;
            PG8_LDB(B0, 1, 0); PG8_LDB(B1, 1, 1); PG8_SCHED; PG8_LDA(At, 1, 0); PG8_STAGE(PG8_SA(0, 1), a2 + hstep, voffA);
            PG8_WAIT_V(8); PG8_WAIT_L(0); PG8_BAR; PG8_MMA(0, 0, At, B0); PG8_MMA(0, 1, At, B1); PG8_BAR; PG8_SCHED;
            PG8_LDA(At, 1, 1); PG8_STAGE(PG8_SB(1, 0), b3, voffB); PG8_STAGE(PG8_SB(1, 1), b3 + hstep, voffB); PG8_STAGE(PG8_SA(1, 0), a3, voffA);
            PG8_WAIT_V(8); PG8_WAIT_L(0); PG8_BAR; PG8_MMA(1, 0, At, B0); PG8_MMA(1, 1, At, B1); PG8_BAR; PG8_SCHED;
            } else {
            PG8_LDB(B0, 0, 0); PG8_SCHED; PG8_LDA(At, 0, 0); PG8_STAGE(PG8_SA(1, 1), a1 + hstep, voffA);
            PG8_WAIT_L(8); PG8_BAR; PG8_WAIT_L(0); PG8_MMA(0, 0, At, B0); PG8_BAR; PG8_SCHED;
            PG8_LDB(B1, 0, 1); PG8_STAGE(PG8_SB(0, 0), b2, voffB);
            PG8_BAR; PG8_WAIT_L(0); PG8_MMA(0, 1, At, B1); PG8_BAR;
            PG8_LDA(At, 0, 1); PG8_STAGE(PG8_SA(0, 0), a2, voffA);
            PG8_BAR; PG8_WAIT_L(0); PG8_MMA(1, 0, At, B0); PG8_BAR; PG8_SCHED;
            PG8_STAGE(PG8_SB(0, 1), b2 + hstep, voffB);
            PG8_WAIT_V(6); PG8_BAR; PG8_MMA(1, 1, At, B1); PG8_BAR;
            PG8_LDB(B0, 1, 0); PG8_SCHED; PG8_LDA(At, 1, 0); PG8_STAGE(PG8_SA(0, 1), a2 + hstep, voffA);
            PG8_WAIT_L(8); PG8_BAR; PG8_WAIT_L(0); PG8_MMA(0, 0, At, B0); PG8_BAR; PG8_SCHED;
            PG8_LDB(B1, 1, 1); PG8_STAGE(PG8_SB(1, 0), b3, voffB);
            PG8_BAR; PG8_WAIT_L(0); PG8_MMA(0, 1, At, B1); PG8_BAR;
            PG8_LDA(At, 1, 1); PG8_STAGE(PG8_SA(1, 0), a3, voffA);
            PG8_BAR; PG8_WAIT_L(0); PG8_MMA(1, 0, At, B0); PG8_BAR; PG8_SCHED;
            PG8_STAGE(PG8_SB(1, 1), b3 + hstep, voffB);
            PG8_WAIT_V(6); PG8_BAR; PG8_MMA(1, 1, At, B1); PG8_BAR;
            }
        }
        if constexpr (ALIGN_EPI) { if (wr == 0) PG8_BAR; }
        if constexpr (!Epi::AFTER_DRAIN) { E(acc, cur, wr, wc, fr, fq); S.done(cur); }
        if (!has_next) break;
#pragma unroll
        for (int a = 0; a < 2; ++a)
#pragma unroll
            for (int b = 0; b < 2; ++b)
#pragma unroll
                for (int m = 0; m < 4; ++m)
#pragma unroll
                    for (int n = 0; n < 2; ++n) acc[a][b][m][n] = (f32x4){0.f, 0.f, 0.f, 0.f};
        cur = nxt; cA = nA; cB = nB; ++ui;
        if constexpr (ALIGN_EPI) { if (wr == 1) PG8_BAR; }
    }
    PG8_WAIT_V(0);
    if constexpr (!ALIGN_EPI) { if (wr == 0) PG8_BAR; }
    PG8_BAR;
    if constexpr (Epi::AFTER_DRAIN) { E.fused(acc, cur, wr, wc, fr, fq, lds, wid, lane); S.done(cur); }
#undef PG8_SA
#undef PG8_SB
#undef PG8_STAGE
#undef PG8_LDA
#undef PG8_LDB
#undef PG8_MMA
#undef PG8_WAIT_V
#undef PG8_WAIT_L
#undef PG8_BAR
#undef PG8_SCHED
}
}

#ifndef PG8_SP2
#define PG8_SP2 true
#endif
#ifndef PG8_ALIGN
#define PG8_ALIGN true
#endif
#define GAS __attribute__((address_space(1)))
#define LAS __attribute__((address_space(3)))
typedef unsigned short bf16;
typedef unsigned v4u __attribute__((ext_vector_type(4)));
typedef float f32x4 __attribute__((ext_vector_type(4)));
typedef short bf16x8 __attribute__((ext_vector_type(8)));
typedef GAS unsigned gu32;
typedef GAS unsigned long long gu64;
#define RLX_AGENT __ATOMIC_RELAXED, __HIP_MEMORY_SCOPE_AGENT
#define LDS_WAIT() asm volatile("s_waitcnt lgkmcnt(0)" ::: "memory")
#define VM_WAIT() asm volatile("s_waitcnt vmcnt(0)" ::: "memory")
__device__ __forceinline__ unsigned long long rt() { return __builtin_amdgcn_s_memrealtime(); }
__device__ __forceinline__ unsigned f2bf(float f) { unsigned u = __builtin_bit_cast(unsigned, f); return (u + 0x7fffu + ((u >> 16) & 1u)) >> 16; }
__device__ __forceinline__ unsigned pk2(float lo, float hi) { return f2bf(lo) | (f2bf(hi) << 16); }

#define XB_TMO      128
#define XB_XCNT(j)  (256  + 64 * (j))
#define XB_XSUB(j)  (1280 + 64 * (j))
#define XB_XGEN(j)  (2304 + 64 * (j))
#define XB_TOP      3328
#define XB_TOPGEN   3392
#define XCD_BAR_WORDS 3456
#define XB_SPIN_CAP (1u << 18)

__device__ __forceinline__ unsigned xb_ld(unsigned* p)              { return __hip_atomic_load(p, __ATOMIC_RELAXED, __HIP_MEMORY_SCOPE_AGENT); }
__device__ __forceinline__ unsigned xb_add(unsigned* p, unsigned v) { return __hip_atomic_fetch_add(p, v, __ATOMIC_RELAXED, __HIP_MEMORY_SCOPE_AGENT); }
__device__ __forceinline__ unsigned xb_xcc_id() { return (unsigned)__builtin_amdgcn_s_getreg((3 << 11) | 20) & 0xFu; }
#define XB_SPIN(cond, bar) do { unsigned _sp = 0; while (cond) { __builtin_amdgcn_s_sleep(1); \
    if ((++_sp & 255u) == 0u) { if (xb_ld(&(bar)[XB_TMO])) break; if (_sp > XB_SPIN_CAP) { atomicAdd(&(bar)[XB_TMO], 1u); break; } } } } while (0)

struct XcdBarrier {
    unsigned* bar; unsigned x;
    volatile LAS unsigned* st;
};

__device__ __forceinline__ XcdBarrier xcd_barrier_post(unsigned* bar, volatile LAS unsigned* st) {
    XcdBarrier b; b.bar = bar; b.x = xb_xcc_id(); b.st = st;
    if (threadIdx.x == 0) (void)xb_add(&bar[XB_XCNT(b.x)], 1u);
    return b;
}
__device__ __forceinline__ void xcd_barrier_complete(unsigned* bar, unsigned x, unsigned& nloc, unsigned& nx) {
    const unsigned G = gridDim.x * gridDim.y * gridDim.z;
    unsigned sum, cnt, mine, sp = 0u;
    for (;;) {
        sum = 0u; cnt = 0u; mine = 0u;
#pragma unroll
        for (unsigned j = 0; j < 16; ++j) { const unsigned c = xb_ld(&bar[XB_XCNT(j)]); sum += c; cnt += (c > 0u) ? 1u : 0u; mine = (j == x) ? c : mine; }
        if (sum == G) break;
        __builtin_amdgcn_s_sleep(1);
        if ((++sp & 255u) == 0u) { if (xb_ld(&bar[XB_TMO])) break; if (sp > XB_SPIN_CAP) { atomicAdd(&bar[XB_TMO], 1u); break; } }
    }
    nloc = mine > 0u ? mine : 1u; nx = cnt > 0u ? cnt : 1u;
}

__device__ __forceinline__ void xcd_barrier(const XcdBarrier& b) {
    asm volatile("s_waitcnt vmcnt(0)" ::: "memory");
    __syncthreads();
    if (threadIdx.x == 0) {
        unsigned* bar = b.bar;
        __builtin_amdgcn_s_waitcnt(0);
        unsigned nloc = b.st[0], nx = b.st[1];
        if (nloc == 0u) { xcd_barrier_complete(bar, b.x, nloc, nx); b.st[0] = nloc; b.st[1] = nx; }
        const unsigned old = xb_add(&bar[XB_XSUB(b.x)], 1u);
        const unsigned gen = old / nloc;
        if (old + 1u == (gen + 1u) * nloc) {
            __builtin_amdgcn_fence(__ATOMIC_RELEASE, "agent");
            asm volatile("s_waitcnt vmcnt(0)" ::: "memory");
            const unsigned og = xb_add(&bar[XB_TOP], 1u);
            const unsigned tg = og / nx;
            if (og + 1u == (tg + 1u) * nx) xb_add(&bar[XB_TOPGEN], 1u);
            else XB_SPIN(xb_ld(&bar[XB_TOPGEN]) == tg, bar);
            __builtin_amdgcn_fence(__ATOMIC_ACQUIRE, "agent");
            xb_add(&bar[XB_XGEN(b.x)], 1u);
            asm volatile("s_waitcnt vmcnt(0)" ::: "memory");
        } else {
            XB_SPIN(xb_ld(&bar[XB_XGEN(b.x)]) == gen, bar);
            __builtin_amdgcn_fence(__ATOMIC_ACQUIRE, "agent");
            asm volatile("s_waitcnt vmcnt(0)" ::: "memory");
        }
    }
    __syncthreads();
}
constexpr int NWAVES = 8;
constexpr int BATCH = 4, T = 4096, D = 1024, M = BATCH * T;
constexpr int RW_W = 512, RW_COLS = 2304, HG_COLS = 2560, IN_COLS = 4864;
constexpr size_t MiB = 1u << 20;
constexpr size_t WS_CTL = 0, CTL_ZERO_BYTES = 1 * MiB;
constexpr size_t WS_P = 1 * MiB;
constexpr size_t WS_XN = 153 * MiB;
constexpr size_t WS_WIN = 185 * MiB;
constexpr size_t WS_WOUT = 249 * MiB;
constexpr size_t WS_BON = 251 * MiB;
constexpr size_t WS_END = 256 * MiB;
constexpr int CW_TMO = 0, CW_CODE = 1, CW_BAR = 4096;
constexpr int RING_OFF = 0, RING_BYTES = 131072;
constexpr int LDSCTL_OFF = RING_BYTES, MISC_OFF = LDSCTL_OFF + 320;
constexpr int LDS_BYTES = 147456;
__device__ __forceinline__ float wave_sum(float v) {
#pragma unroll
    for (int o = 1; o < 64; o <<= 1) v += __shfl_xor(v, o);
    return v;
}
__device__ __forceinline__ void p0_transpose_item(const float* W, int K, int N, bf16* WT, LAS float* scr, int item, int lane) {
    const int nblk = N / 32, kb = item / nblk, nb = item % nblk, k0 = 64 * kb, n0 = 32 * nb;
#pragma unroll 8
    for (int i = 0; i < 32; ++i) { const int kk = 2 * i + (lane >> 5); scr[kk * 33 + (lane & 31)] = W[(size_t)(k0 + kk) * N + n0 + (lane & 31)]; }
    LDS_WAIT(); asm volatile("" ::: "memory");
    const int c = lane & 7;
#pragma unroll
    for (int j = 0; j < 4; ++j) { const int n = (lane >> 3) + 8 * j; const LAS float* s = scr + (8 * c) * 33 + n;
        v4u o; o.x = pk2(s[0 * 33], s[1 * 33]); o.y = pk2(s[2 * 33], s[3 * 33]); o.z = pk2(s[4 * 33], s[5 * 33]); o.w = pk2(s[6 * 33], s[7 * 33]);
        *(GAS v4u*)(WT + (size_t)(n0 + n) * K + k0 + 8 * c) = o; }
    LDS_WAIT(); asm volatile("" ::: "memory");
}
__device__ __forceinline__ void rms_row_to_bf16(const float* xrow, const float* g, bf16* orow, int lane) {
    const GAS f32x4* xr = (const GAS f32x4*)xrow + lane;
    const GAS f32x4* gr = (const GAS f32x4*)g + lane;
    f32x4 v[4]; float s = 0.f;
#pragma unroll
    for (int j = 0; j < 4; ++j) { v[j] = xr[64 * j]; s += (v[j].x * v[j].x + v[j].y * v[j].y) + (v[j].z * v[j].z + v[j].w * v[j].w); }
    const float rstd = 1.f / sqrtf(wave_sum(s) * (1.f / D) + 1e-6f);
    GAS unsigned long long* o8 = (GAS unsigned long long*)orow + lane;
#pragma unroll
    for (int j = 0; j < 4; ++j) { const f32x4 gv = gr[64 * j];
        o8[64 * j] = (unsigned long long)pk2(v[j].x * rstd * gv.x, v[j].y * rstd * gv.y) | ((unsigned long long)pk2(v[j].z * rstd * gv.z, v[j].w * rstd * gv.w) << 32); }
}

__device__ __forceinline__ float bfu(bf16 b) { return __uint_as_float(((unsigned)b) << 16); }
__device__ __forceinline__ float shifted_tok(const bf16* __restrict__ p, int b, int t, int c, float mup, float mun) {
    const size_t row = (size_t)b * T + t;
    const float cur = bfu(p[row * IN_COLS + c]);
    const float prv = t > 0 ? bfu(p[(row - 1) * IN_COLS + c]) : 0.f;
    const float nxt = t < T - 1 ? bfu(p[(row + 1) * IN_COLS + c]) : 0.f;
    return cur + mup * (prv - cur) + mun * (nxt - cur);
}
__device__ __forceinline__ float sigmoidf_(float v) { return 1.0f / (1.0f + __expf(-v)); }

__device__ __forceinline__ void rw_scan_naive(const bf16* __restrict__ p, const float* const* in, float* __restrict__ y_out, float* __restrict__ bonus, LAS float* sm, int seq, int wsub, int lane) {
    const float* mu_prev = in[3]; const float* mu_next = in[4]; const float* w0 = in[5]; const float* w2 = in[6]; const float* a0 = in[7]; const float* a2 = in[8];
    const float* k_k = in[9]; const float* k_a = in[10]; const float* r_k = in[11];
    const int h = seq & 7, b = (seq >> 3) & 3, d = seq >> 5;
    const int c = h * 64 + lane;
    const float mp_r = mu_prev[c], mn_r = mu_next[c], mp_k = mu_prev[512 + c], mn_k = mu_next[512 + c], mp_v = mu_prev[1024 + c], mn_v = mu_next[1024 + c];
    const int cw = 2048 + d * 64 + lane, ca = 2176 + d * 64 + lane;
    const float mp_w = mu_prev[cw], mn_w = mu_next[cw], mp_a = mu_prev[ca], mn_a = mu_next[ca];
    const float w0c = w0[d * 512 + c], a0c = a0[d * 512 + c], kkc = k_k[c], kac = k_a[c], rkc = r_k[c];
    const float* w2p = w2 + (size_t)d * 64 * 512 + c;
    const float* a2p = a2 + (size_t)d * 64 * 512 + c;
    LAS float* lo0 = sm; LAS float* lo1 = sm + 64; LAS float* vec = sm + 128;
    const int ri = 16 * wsub + (lane >> 2), q16 = (lane & 3) * 16;
    float S[16];
#pragma unroll
    for (int j = 0; j < 16; ++j) S[j] = 0.f;
    for (int s = 0; s < T; ++s) {
        const int t = d ? (T - 1 - s) : s;
        const float rs = shifted_tok(p, b, t, c, mp_r, mn_r);
        const float ks = shifted_tok(p, b, t, 512 + c, mp_k, mn_k);
        const float vs = shifted_tok(p, b, t, 1024 + c, mp_v, mn_v);
        const float wd = shifted_tok(p, b, t, cw, mp_w, mn_w);
        const float ad = shifted_tok(p, b, t, ca, mp_a, mn_a);
        __builtin_amdgcn_wave_barrier();
        lo0[lane] = tanhf(wd); lo1[lane] = ad;
        __builtin_amdgcn_wave_barrier();
        float wr = w0c, ar = a0c;
#pragma unroll 4
        for (int r = 0; r < 64; ++r) { wr += lo0[r] * w2p[(size_t)r * 512]; ar += lo1[r] * a2p[(size_t)r * 512]; }
        const float sp = (-wr > 20.f) ? -wr : log1pf(expf(-wr));
        const float decay = expf(-expf(-sp - 0.5f));
        const float a = 1.0f / (1.0f + expf(-ar));
        float kkv = ks * kkc;
        const float nrm = sqrtf(wave_sum(kkv * kkv));
        kkv = kkv / fmaxf(nrm, 1e-12f);
        const float kd = ks * (1.0f + (a - 1.0f) * kac);
        const float bb = kkv * a;
        const float bo = wave_sum(rs * kd * rkc);
        if (lane == 0 && wsub == 0) bonus[((size_t)d * M + (size_t)b * T + t) * 8 + h] = bo;
        vec[lane] = decay; vec[64 + lane] = kd; vec[128 + lane] = kkv; vec[192 + lane] = bb; vec[256 + lane] = rs; vec[320 + lane] = vs;
        __builtin_amdgcn_wave_barrier();
        const float vi = vec[320 + ri];
        float sa = 0.f;
#pragma unroll
        for (int j = 0; j < 16; ++j) sa += S[j] * vec[128 + q16 + j];
        sa += __shfl_xor(sa, 1); sa += __shfl_xor(sa, 2);
        float y = 0.f;
#pragma unroll
        for (int j = 0; j < 16; ++j) { S[j] = S[j] * vec[q16 + j] - sa * vec[192 + q16 + j] + vi * vec[64 + q16 + j]; y += S[j] * vec[256 + q16 + j]; }
        y += __shfl_xor(y, 1); y += __shfl_xor(y, 2);
        if ((lane & 3) == 0) y_out[((size_t)d * M + (size_t)b * T + t) * 512 + h * 64 + ri] = y;
    }
}
__device__ __forceinline__ void hg_scan_naive(const bf16* __restrict__ p, const float* __restrict__ lb_logits, float* __restrict__ o_out, LAS float* sm, int item, int lane) {
    const int vq = item & 3, h = (item >> 2) & 3, b = (item >> 4) & 3, d = item >> 6;
    const int ck0 = h * 128 + lane, ck1 = ck0 + 64, cv = h * 128 + vq * 32 + (lane >> 1), k0 = (lane & 1) * 64;
    const float lb0 = sigmoidf_(lb_logits[ck0] - lb_logits[512 + ck0]), lb1 = sigmoidf_(lb_logits[ck1] - lb_logits[512 + ck1]);
    float S[64];
#pragma unroll
    for (int j = 0; j < 64; ++j) S[j] = 0.f;
    for (int s = 0; s < T; ++s) {
        const int t = d ? (T - 1 - s) : s;
        const size_t row = (size_t)b * T + t;
        const bf16* pr = p + row * IN_COLS + RW_COLS;
        const float q0 = bfu(pr[ck0]), q1 = bfu(pr[ck1]);
        const float z0 = bfu(pr[512 + d * 512 + ck0]), z1 = bfu(pr[512 + d * 512 + ck1]);
        const float iv = bfu(pr[1536 + cv]);
        __builtin_amdgcn_wave_barrier();
        sm[lane] = lb0 + (1.0f - lb0) / (1.0f + expf(-z0)); sm[64 + lane] = lb1 + (1.0f - lb1) / (1.0f + expf(-z1));
        sm[128 + lane] = q0; sm[192 + lane] = q1;
        __builtin_amdgcn_wave_barrier();
        float o = 0.f;
#pragma unroll
        for (int k = 0; k < 64; ++k) { const float fk = sm[k0 + k]; S[k] = fk * S[k] + (1.0f - fk) * iv; o += sm[128 + k0 + k] * S[k]; }
        o += __shfl_xor(o, 1);
        if ((lane & 1) == 0) o_out[((size_t)d * M + row) * 512 + cv] = o;
    }
}
__device__ __forceinline__ void mix_row(const bf16* __restrict__ p, const float* const* in, const float* __restrict__ y_rw, const float* __restrict__ bonus, const float* __restrict__ o_hg, bf16* __restrict__ ymix, int row, int lane) {
    const float* mu_prev = in[3]; const float* mu_next = in[4]; const float* ln_w = in[12]; const float* ln_b = in[13]; const float* norm_g = in[15];
    const int b = row / T, t = row % T;
#pragma unroll 2
    for (int i = 0; i < 8; ++i) {
        const int c = i * 64 + lane;
        const float y = y_rw[(size_t)row * 512 + c] + y_rw[((size_t)M + row) * 512 + c];
        const float mu = wave_sum(y) * (1.0f / 64.0f);
        const float dlt = y - mu;
        const float var = wave_sum(dlt * dlt) * (1.0f / 64.0f);
        float yn = dlt * (1.0f / sqrtf(var + 64e-5f)) * ln_w[c] + ln_b[c];
        const float vs = shifted_tok(p, b, t, 1024 + c, mu_prev[1024 + c], mu_next[1024 + c]);
        const float gs = shifted_tok(p, b, t, 1536 + c, mu_prev[1536 + c], mu_next[1536 + c]);
        const float bo = bonus[(size_t)row * 8 + i] + bonus[((size_t)M + row) * 8 + i];
        yn += bo * vs;
        ymix[(size_t)row * 1024 + c] = (bf16)f2bf(yn * gs * sigmoidf_(gs));
    }
#pragma unroll
    for (int hh = 0; hh < 4; ++hh) {
        const int c0 = hh * 128 + lane, c1 = c0 + 64;
        const float o0 = o_hg[(size_t)row * 512 + c0] + o_hg[((size_t)M + row) * 512 + c0];
        const float o1 = o_hg[(size_t)row * 512 + c1] + o_hg[((size_t)M + row) * 512 + c1];
        const float rstd = 1.0f / sqrtf(wave_sum(o0 * o0 + o1 * o1) * (1.0f / 128.0f) + 1e-6f);
        const float g0 = bfu(p[(size_t)row * IN_COLS + RW_COLS + 2048 + c0]), g1 = bfu(p[(size_t)row * IN_COLS + RW_COLS + 2048 + c1]);
        ymix[(size_t)row * 1024 + 512 + c0] = (bf16)f2bf(o0 * rstd * norm_g[lane] * g0 * sigmoidf_(g0));
        ymix[(size_t)row * 1024 + 512 + c1] = (bf16)f2bf(o1 * rstd * norm_g[64 + lane] * g1 * sigmoidf_(g1));
    }
}
__device__ __forceinline__ void post_row(const float* xrow, const float* yrow, const float* g, float* orow, int lane) {
    const GAS f32x4* yr = (const GAS f32x4*)yrow + lane; const GAS f32x4* xr = (const GAS f32x4*)xrow + lane; const GAS f32x4* gr = (const GAS f32x4*)g + lane;
    f32x4 v[4]; float s = 0.f;
#pragma unroll
    for (int j = 0; j < 4; ++j) { v[j] = yr[64 * j]; s += (v[j].x * v[j].x + v[j].y * v[j].y) + (v[j].z * v[j].z + v[j].w * v[j].w); }
    const float rstd = 1.f / sqrtf(wave_sum(s) * (1.f / D) + 1e-6f);
    GAS f32x4* o4 = (GAS f32x4*)orow + lane;
#pragma unroll
    for (int j = 0; j < 4; ++j) o4[64 * j] = xr[64 * j] + v[j] * rstd * gr[64 * j];
}
struct Args { const float* in[18]; float* out; unsigned char* ws; int ph_lo, ph_hi; };
__global__ void __launch_bounds__(NWAVES * 64, 2) mega(Args args) {
    extern __shared__ __attribute__((aligned(16))) unsigned char lds_raw[];
    LAS unsigned char* lds = (LAS unsigned char*)lds_raw;
    volatile LAS unsigned* MISC = (volatile LAS unsigned*)(lds + MISC_OFF);
    const int tid = threadIdx.x, lane = tid & 63, wave = __builtin_amdgcn_readfirstlane(tid >> 6);
    const int G = gridDim.x;
    const int vcu = (G % 8 == 0) ? ((int)blockIdx.x % 8) * (G / 8) + (int)blockIdx.x / 8 : (int)blockIdx.x;
    unsigned char* ws = args.ws;
    gu32* ctl = (gu32*)(ws + WS_CTL);
    for (int u = tid; u < (LDS_BYTES - LDSCTL_OFF) / 4; u += NWAVES * 64) ((LAS unsigned*)(lds + LDSCTL_OFF))[u] = 0u;
    __syncthreads();
    XcdBarrier bar = xcd_barrier_post((unsigned*)(ctl + CW_BAR), MISC + 8);
    const int lo = args.ph_lo, hi = args.ph_hi;
#define IN(k) (lo <= (k) && (k) < hi)
#define BOTH(k) (IN(k) && IN((k) + 1))
    const float* x = args.in[0]; const float* pre_g = args.in[1]; const float* w_in = args.in[2]; const float* w_out = args.in[16];
    bf16* P = (bf16*)(ws + WS_P); bf16* XN = (bf16*)(ws + WS_XN); bf16* WIN_T = (bf16*)(ws + WS_WIN); bf16* WOUT_T = (bf16*)(ws + WS_WOUT);

    if (IN(0)) {
        LAS float* scr = (LAS float*)(lds + RING_OFF + wave * 16384);
        const int gw = vcu * NWAVES + wave, NGW = G * NWAVES;
        constexpr int I_IN = (D / 64) * (IN_COLS / 32), I_OUT = (D / 64) * (D / 32);
        for (int it = gw; it < I_IN + I_OUT; it += NGW) {
            if (it < I_IN) p0_transpose_item(w_in, D, IN_COLS, WIN_T, scr, it, lane);
            else p0_transpose_item(w_out, D, D, WOUT_T, scr, it - I_IN, lane);
        }
        for (int m = gw; m < M; m += NGW) rms_row_to_bf16(x + (size_t)m * D, pre_g, XN + (size_t)m * D, lane);
        if (BOTH(0)) xcd_barrier(bar);
    }
    if (IN(1)) {
        pg8::Gemm g{XN, WIN_T, M, IN_COLS, D}; pg8::StaticOrder S; S.init(M, IN_COLS, G, (int)blockIdx.x);
        pg8::EpiBf16<0> E{P, IN_COLS, nullptr, 0, 0, 1.f};
        pg8::gemm_phase<pg8::EpiBf16<0>, pg8::StaticOrder, PG8_ALIGN, PG8_SP2>(lds + RING_OFF, g, S, E);
        if (BOTH(1)) xcd_barrier(bar);
    }
    float* YRW = (float*)(ws + 185 * MiB); float* OHG = args.out; float* BON = (float*)(ws + WS_BON); bf16* YMIX = XN; float* Y = YRW;
    if (IN(2)) {
        {
            LAS float* sm = (LAS float*)(lds + RING_OFF + wave * 4096);
            if ((int)blockIdx.x < 64) { if (wave < 4) rw_scan_naive(P, args.in, YRW, BON, sm, (int)blockIdx.x, wave, lane); }
            else if ((int)blockIdx.x < 128) { if (wave < 2) hg_scan_naive(P, args.in[14], OHG, sm, ((int)blockIdx.x - 64) * 2 + wave, lane); }
        }
        if (BOTH(2)) xcd_barrier(bar);
    }
    if (IN(3)) {
        const int gw = vcu * NWAVES + wave, NGW = G * NWAVES;
        for (int m = gw; m < M; m += NGW) mix_row(P, args.in, YRW, BON, OHG, YMIX, m, lane);
        if (BOTH(3)) xcd_barrier(bar);
    }
    if (IN(4)) {
        pg8::Gemm g{YMIX, WOUT_T, M, D, D}; pg8::StaticOrder S; S.init(M, D, G, (int)blockIdx.x);
        pg8::EpiF32 E{Y, D, nullptr};
        pg8::gemm_phase<pg8::EpiF32, pg8::StaticOrder, PG8_ALIGN, PG8_SP2>(lds + RING_OFF, g, S, E);
        if (BOTH(4)) xcd_barrier(bar);
    }
    if (IN(5)) {
        const int gw = vcu * NWAVES + wave, NGW = G * NWAVES;
        for (int m = gw; m < M; m += NGW) post_row(x + (size_t)m * D, Y + (size_t)m * D, args.in[17], args.out + (size_t)m * D, lane);
    }
#undef IN
#undef BOTH
}
extern "C" void kernel_launch(void* const* d_in, const int* in_sizes, int n_in, void* d_out, int out_size, void* d_ws, size_t ws_size, hipStream_t stream) {
    static int grid = 0;
    if (grid == 0) {
        int dev = 0, cus = 0;
        if (hipGetDevice(&dev) != hipSuccess || hipDeviceGetAttribute(&cus, hipDeviceAttributeMultiprocessorCount, dev) != hipSuccess) { fprintf(stderr, "kernel_launch: device query failed\n"); grid = -1; return; }
        if (hipFuncSetAttribute((const void*)mega, hipFuncAttributeMaxDynamicSharedMemorySize, LDS_BYTES) != hipSuccess) { fprintf(stderr, "kernel_launch: hipFuncSetAttribute failed\n"); grid = -1; return; }
        (void)hipGetLastError();
        grid = cus;
    }
    if (grid < 0) return;
    (void)hipMemsetAsync((char*)d_ws + WS_CTL, 0, CTL_ZERO_BYTES, stream);
    Args a{};
    for (int i = 0; i < 18; ++i) a.in[i] = (const float*)d_in[i];
    a.out = (float*)d_out; a.ws = (unsigned char*)d_ws; a.ph_lo = 0; a.ph_hi = 6;
    hipLaunchKernelGGL(mega, dim3(grid), dim3(NWAVES * 64), LDS_BYTES, stream, a);
}
```

```cpp
#include <hip/hip_runtime.h>
#include <cstdio>
#include <cstdint>
namespace pg8 {
#define PG8_LAS __attribute__((address_space(3)))
typedef unsigned short bf16_t;
typedef short bf16x8 __attribute__((ext_vector_type(8)));
typedef float f32x4 __attribute__((ext_vector_type(4)));
typedef unsigned u32x4 __attribute__((ext_vector_type(4)));
constexpr int BM = 256, BK = 64, HALF = 128, HTB = HALF * BK * 2  , STAGE_BYTES = 8 * HTB, NXCD = 8, WGM = 8;

__host__ __device__ __forceinline__ int lds_byte(int r, int c) { const int st = (r >> 4) * 2 + (c >> 5), rr = r & 15, cc = c & 31, ob = rr * 64 + cc * 2; return st * 1024 + (ob ^ (((ob >> 9) & 1) << 5)); }
__host__ __device__ __forceinline__ void stage_rc(int b, int& R, int& C) { const int st = b / 1024, sb = b % 1024, swz = sb ^ (((sb >> 9) & 1) << 5); R = (st >> 1) * 16 + swz / 64; C = (st & 1) * 32 + (swz % 64) / 2; }
__host__ __device__ __forceinline__ int perm32(int rho) { const int n = rho >> 4, i = rho & 15; return 8 * (i >> 2) + 4 * n + (i & 3); }

struct Unit { int pm, pn; };
struct Gemm { const bf16_t* A; const bf16_t* Bt; int M, N, K; };

struct StaticOrder {
    int nM, nN, nwg, G, c;
    __host__ __device__ void init(int M, int N, int G_, int c_) { nM = M / BM; nN = N / BM; nwg = nM * nN; G = G_; c = c_; }
    __host__ __device__ bool next(int i, Unit& u) const {
        const long L = (long)i * G + c; if (L >= nwg) return false;
        int wgid = (int)L; { const int q = nwg / NXCD, r = nwg % NXCD, xcd = wgid % NXCD, off = wgid / NXCD; wgid = (xcd < r ? xcd * (q + 1) : r * (q + 1) + (xcd - r) * q) + off; }
        const int nig = WGM * nN, gid = wgid / nig, fm = gid * WGM, gsz = (nM - fm) < WGM ? (nM - fm) : WGM;
        u.pm = fm + ((wgid % nig) % gsz); u.pn = (wgid % nig) / gsz; return true;
    }
    __device__ __forceinline__ void a_ready(const Unit&) const {}
    __device__ __forceinline__ void done(const Unit&) const {}
};

__device__ __forceinline__ unsigned cvt_pk_bf16(float lo, float hi) { unsigned r; asm volatile("v_cvt_pk_bf16_f32 %0, %1, %2" : "=v"(r) : "v"(lo), "v"(hi)); return r; }
typedef float f32x2 __attribute__((ext_vector_type(2)));
__device__ __forceinline__ f32x2 gelu_pk(f32x2 v) {
    const f32x2 av = __builtin_elementwise_abs(v), d = av * 0.2316418882f + 1.0f;
    f32x2 t; t.x = __builtin_amdgcn_rcpf(d.x); t.y = __builtin_amdgcn_rcpf(d.y);
    f32x2 q = t * 0.5307027145f + (-0.7265760135f); q = q * t + 0.7107068705f; q = q * t + (-0.142248368f); q = q * t + 0.127414796f; q = q * t;
    const f32x2 s = (v * v) * (-0.72134752044f);
    f32x2 e; e.x = __builtin_amdgcn_exp2f(s.x); e.y = __builtin_amdgcn_exp2f(s.y);
    const f32x2 m = v * (q * e), r = v - m;
    f32x2 o; o.x = v.x < 0.f ? m.x : r.x; o.y = v.y < 0.f ? m.y : r.y; return o;
}

template <int ACT  > struct EpiBf16 {
    static constexpr bool PERM = true, AFTER_DRAIN = false; static_assert(ACT == 0 || ACT == 1, "EpiBf16: ACT is 0 (none) or 1 (gelu_pk)");
    bf16_t* O; int ldc; const float* bias; int split_cols; size_t split_stride; float scale0;
    __device__ __forceinline__ void operator()(const f32x4 (&acc)[2][2][4][2], const Unit& u, int wr, int wc, int fr, int fq) const {
        const int row0 = u.pm * BM + wr * 64 + fr; int colt = u.pn * BM; bf16_t* base = O;
        float sc = 1.f; if (split_cols) { const int t = colt / split_cols; base += (size_t)t * split_stride; colt -= t * split_cols; if (t == 0) sc = scale0; }
        const int col0 = colt + wc * 32 + 8 * fq, bcol0 = u.pn * BM + wc * 32 + 8 * fq;
        f32x4 bv[2][2];
#pragma unroll
        for (int bj = 0; bj < 2; ++bj)
#pragma unroll
            for (int n = 0; n < 2; ++n) bv[bj][n] = bias ? *(const f32x4*)(bias + bcol0 + bj * HALF + 4 * n) : (f32x4){0.f, 0.f, 0.f, 0.f};
#pragma unroll
        for (int ai = 0; ai < 2; ++ai)
#pragma unroll
            for (int m = 0; m < 4; ++m) { bf16_t* rowp = base + (size_t)(row0 + ai * HALF + m * 16) * ldc + col0;
#pragma unroll
                for (int bj = 0; bj < 2; ++bj) { f32x4 v0 = acc[ai][bj][m][0] + bv[bj][0], v1 = acc[ai][bj][m][1] + bv[bj][1];
                    if (ACT == 1) { f32x2 a = gelu_pk((f32x2){v0[0], v0[1]}), b = gelu_pk((f32x2){v0[2], v0[3]}), c = gelu_pk((f32x2){v1[0], v1[1]}), d = gelu_pk((f32x2){v1[2], v1[3]});
                        v0 = (f32x4){a.x, a.y, b.x, b.y}; v1 = (f32x4){c.x, c.y, d.x, d.y}; }
                    v0 = v0 * sc; v1 = v1 * sc; u32x4 w; w.x = cvt_pk_bf16(v0[0], v0[1]); w.y = cvt_pk_bf16(v0[2], v0[3]); w.z = cvt_pk_bf16(v1[0], v1[1]); w.w = cvt_pk_bf16(v1[2], v1[3]);
                    *(u32x4*)(rowp + bj * HALF) = w; } }
    }
};
struct EpiF32 {
    static constexpr bool PERM = false, AFTER_DRAIN = false;
    float* C; int ldc; const float* bias;
    __device__ __forceinline__ void operator()(const f32x4 (&acc)[2][2][4][2], const Unit& u, int wr, int wc, int fr, int fq) const {
        const int row0 = u.pm * BM + wr * 64 + fr, col0 = u.pn * BM + wc * 32 + 4 * fq;
        f32x4 bv[2][2];
#pragma unroll
        for (int bj = 0; bj < 2; ++bj)
#pragma unroll
            for (int n = 0; n < 2; ++n) bv[bj][n] = bias ? *(const f32x4*)(bias + col0 + bj * HALF + n * 16) : (f32x4){0.f, 0.f, 0.f, 0.f};
#pragma unroll
        for (int ai = 0; ai < 2; ++ai)
#pragma unroll
            for (int m = 0; m < 4; ++m) { float* rowp = C + (size_t)(row0 + ai * HALF + m * 16) * ldc + col0;
#pragma unroll
                for (int bj = 0; bj < 2; ++bj)
#pragma unroll
                    for (int n = 0; n < 2; ++n) *(f32x4*)(rowp + bj * HALF + n * 16) = acc[ai][bj][m][n] + bv[bj][n]; }
    }
};
template <class Epi, class Sched, bool ALIGN_EPI = false, bool SP2 = false>
__device__ __forceinline__ void gemm_phase(PG8_LAS unsigned char* lds, const Gemm g, const Sched& S, const Epi& E) {
    const int tid = threadIdx.x, wid = __builtin_amdgcn_readfirstlane(tid >> 6), lane = tid & 63, wr = wid >> 2, wc = wid & 3, fr = lane & 15, fq = lane >> 4;
    const int K = g.K, nt = K / BK;
    unsigned voffA[2], voffB[2];
#pragma unroll
    for (int i = 0; i < 2; ++i) { int R, C; stage_rc(tid * 16 + i * 8192, R, C); const int Rb = Epi::PERM ? ((R & ~31) + perm32(R & 31)) : R;
        voffA[i] = (unsigned)(R * K + C) * 2u; voffB[i] = (unsigned)(Rb * K + C) * 2u; }
    const size_t kstep = (size_t)(BK * 2);
    const size_t hstep = (size_t)HALF * K * 2;
    const size_t tstep = 2 * hstep;
    const unsigned ldsw = (unsigned)wid * 1024u;
    const int aoff = lds_byte(wr * 64 + fr, fq * 8), boff = lds_byte(wc * 32 + fr, fq * 8);
#define PG8_SA(b, h) (((b) * 2 + (h)) * HTB)
#define PG8_SB(b, h) ((4 + (b) * 2 + (h)) * HTB)
#define PG8_STAGE(bufoff, gbase, voff) do { _Pragma("unroll") for (int _i = 0; _i < 2; ++_i) \
        __builtin_amdgcn_global_load_lds((const unsigned*)((const char*)(gbase) + (voff)[_i]), (PG8_LAS unsigned*)(lds + (bufoff) + ldsw + _i * 8192), 16, 0, 0); } while (0)
#define PG8_LDA(dst, b, h) do { _Pragma("unroll") for (int m = 0; m < 4; ++m) _Pragma("unroll") for (int k = 0; k < 2; ++k) dst[m][k] = *(const PG8_LAS bf16x8*)(lds + PG8_SA(b, h) + aoff + m * 2048 + k * 1024); } while (0)
#define PG8_LDB(dst, b, h) do { _Pragma("unroll") for (int n = 0; n < 2; ++n) _Pragma("unroll") for (int k = 0; k < 2; ++k) dst[n][k] = *(const PG8_LAS bf16x8*)(lds + PG8_SB(b, h) + boff + n * 2048 + k * 1024); } while (0)
#define PG8_MMA(ai, bj, At, Bt) do { __builtin_amdgcn_s_setprio(1); _Pragma("unroll") for (int m = 0; m < 4; ++m) _Pragma("unroll") for (int n = 0; n < 2; ++n) _Pragma("unroll") for (int k = 0; k < 2; ++k) \
        acc[ai][bj][m][n] = __builtin_amdgcn_mfma_f32_16x16x32_bf16(Bt[n][k], At[m][k], acc[ai][bj][m][n], 0, 0, 0); __builtin_amdgcn_s_setprio(0); } while (0)
#define PG8_WAIT_V(n) asm volatile("s_waitcnt vmcnt(" #n ")" ::: "memory")
#define PG8_WAIT_L(n) asm volatile("s_waitcnt lgkmcnt(" #n ")" ::: "memory")
#define PG8_BAR __builtin_amdgcn_s_barrier()
#define PG8_SCHED __builtin_amdgcn_sched_barrier(0)
    Unit cur, nxt; int ui = 0;
    if (!S.next(0, cur)) return;
    f32x4 acc[2][2][4][2];
#pragma unroll
    for (int a = 0; a < 2; ++a)
#pragma unroll
        for (int b = 0; b < 2; ++b)
#pragma unroll
            for (int m = 0; m < 4; ++m)
#pragma unroll
                for (int n = 0; n < 2; ++n) acc[a][b][m][n] = (f32x4){0.f, 0.f, 0.f, 0.f};
    bf16x8 At[4][2], B0[2][2], B1[2][2];
    const char* cA = (const char*)g.A + (size_t)cur.pm * tstep; const char* cB = (const char*)g.Bt + (size_t)cur.pn * tstep;
    S.a_ready(cur);
    if constexpr (SP2) {
        PG8_STAGE(PG8_SB(0, 0), cB, voffB); PG8_STAGE(PG8_SB(0, 1), cB + hstep, voffB); PG8_STAGE(PG8_SA(0, 0), cA, voffA); PG8_STAGE(PG8_SA(0, 1), cA + hstep, voffA);
        if (wr == 1) PG8_BAR;
        PG8_WAIT_V(2); PG8_BAR;
        PG8_STAGE(PG8_SB(1, 0), cB + kstep, voffB); PG8_STAGE(PG8_SA(1, 0), cA + kstep, voffA); PG8_STAGE(PG8_SB(1, 1), cB + hstep + kstep, voffB);
        PG8_WAIT_V(6); PG8_BAR;
    } else {
        PG8_STAGE(PG8_SB(0, 0), cB, voffB); PG8_STAGE(PG8_SA(0, 0), cA, voffA); PG8_STAGE(PG8_SB(0, 1), cB + hstep, voffB); PG8_STAGE(PG8_SA(0, 1), cA + hstep, voffA);
        if (wr == 1) PG8_BAR;
        PG8_WAIT_V(4); PG8_BAR;
        PG8_STAGE(PG8_SB(1, 0), cB + kstep, voffB); PG8_STAGE(PG8_SA(1, 0), cA + kstep, voffA); PG8_STAGE(PG8_SB(1, 1), cB + hstep + kstep, voffB);
        PG8_WAIT_V(6); PG8_BAR;
    }
    for (;;) {
        const bool has_next = S.next(ui + 1, nxt);
        const char* nA = has_next ? (const char*)g.A + (size_t)nxt.pm * tstep : cA; const char* nB = has_next ? (const char*)g.Bt + (size_t)nxt.pn * tstep : cB;
        for (int t = 0; t < nt; t += 2) {
            const bool last = (t == nt - 2);
            const char* a1 = cA + (size_t)(t + 1) * kstep;
            const char* a2 = last ? nA : cA + (size_t)(t + 2) * kstep; const char* b2 = last ? nB : cB + (size_t)(t + 2) * kstep;
            const char* a3 = a2 + kstep; const char* b3 = b2 + kstep;
            if (last && has_next) S.a_ready(nxt);
            if constexpr (SP2) {
            PG8_LDB(B0, 0, 0); PG8_LDB(B1, 0, 1); PG8_SCHED; PG8_LDA(At, 0, 0); PG8_STAGE(PG8_SA(1, 1), a1 + hstep, voffA);
            PG8_WAIT_V(8); PG8_WAIT_L(0); PG8_BAR; PG8_MMA(0, 0, At, B0); PG8_MMA(0, 1, At, B1); PG8_BAR; PG8_SCHED;
            PG8_LDA(At, 0, 1); PG8_STAGE(PG8_SB(0, 0), b2, voffB); PG8_STAGE(PG8_SB(0, 1), b2 + hstep, voffB); PG8_STAGE(PG8_SA(0, 0), a2, voffA);
            PG8_WAIT_V(8); PG8_WAIT_L(0); PG8_BAR; PG8_MMA(1, 0, At, B0); PG8_MMA(1, 1, At, B1); PG8_BAR; PG8_SCHED;
            PG8_LDB(B0, 1, 0); PG8_LDB(B1, 1, 1); PG8_SCHED; PG8_LDA(At, 1, 0); PG8_STAGE(PG8_SA(0, 1), a2 + hstep, voffA);
            PG8_WAIT_V(8); PG8_WAIT_L(0); PG8_BAR; PG8_MMA(0, 0, At, B0); PG8_MMA(0, 1, At, B1); PG8_BAR; PG8_SCHED;
            PG8_LDA(At, 1, 1); PG8_STAGE(PG8_SB(1, 0), b3, voffB); PG8_STAGE(PG8_SB(1, 1), b3 + hstep, voffB); PG8_STAGE(PG8_SA(1, 0), a3, voffA);
            PG8_WAIT_V(8); PG8_WAIT_L(0); PG8_BAR; PG8_MMA(1, 0, At, B0); PG8_MMA(1, 1, At, B1); PG8_BAR; PG8_SCHED;
            } else {
            PG8_LDB(B0, 0, 0); PG8_SCHED; PG8_LDA(At, 0, 0); PG8_STAGE(PG8_SA(1, 1), a1 + hstep, voffA);
            PG8_WAIT_L(8); PG8_BAR; PG8_WAIT_L(0); PG8_MMA(0, 0, At, B0); PG8_BAR; PG8_SCHED;
            PG8_LDB(B1, 0, 1); PG8_STAGE(PG8_SB(0, 0), b2, voffB);
            PG8_BAR; PG8_WAIT_L(0); PG8_MMA(0, 1, At, B1); PG8_BAR;
            PG8_LDA(At, 0, 1); PG8_STAGE(PG8_SA(0, 0), a2, voffA);
            PG8_BAR; PG8_WAIT_L(0); PG8_MMA(1, 0, At, B0); PG8_BAR; PG8_SCHED;
            PG8_STAGE(PG8_SB(0, 1), b2 + hstep, voffB);
            PG8_WAIT_V(6); PG8_BAR; PG8_MMA(1, 1, At, B1); PG8_BAR;
            PG8_LDB(B0, 1, 0); PG8_SCHED; PG8_LDA(At, 1, 0); PG8_STAGE(PG8_SA(0, 1), a2 + hstep, voffA);
            PG8_WAIT_L(8); PG8_BAR; PG8_WAIT_L(0); PG8_MMA(0, 0, At, B0); PG8_BAR; PG8_SCHED;
            PG8_LDB(B1, 1, 1); PG8_STAGE(PG8_SB(1, 0), b3, voffB);
            PG8_BAR; PG8_WAIT_L(0); PG8_MMA(0, 1, At, B1); PG8_BAR;
            PG8_LDA(At, 1, 1); PG8_STAGE(PG8_SA(1, 0), a3, voffA);
            PG8_BAR; PG8_WAIT_L(0); PG8_MMA(1, 0, At, B0); PG8_BAR; PG8_SCHED;
            PG8_STAGE(PG8_SB(1, 1), b3 + hstep, voffB);
            PG8_WAIT_V(6); PG8_BAR; PG8_MMA(1, 1, At, B1); PG8_BAR;
            }
        }
        if constexpr (ALIGN_EPI) { if (wr == 0) PG8_BAR; }
        if constexpr (!Epi::AFTER_DRAIN) { E(acc, cur, wr, wc, fr, fq); S.done(cur); }
        if (!has_next) break;
#pragma unroll
        for (int a = 0; a < 2; ++a)
#pragma unroll
            for (int b = 0; b < 2; ++b)
#pragma unroll
                for (int m = 0; m < 4; ++m)
#pragma unroll
                    for (int n = 0; n < 2; ++n) acc[a][b][m][n] = (f32x4){0.f, 0.f, 0.f, 0.f};
        cur = nxt; cA = nA; cB = nB; ++ui;
        if constexpr (ALIGN_EPI) { if (wr == 1) PG8_BAR; }
    }
    PG8_WAIT_V(0);
    if constexpr (!ALIGN_EPI) { if (wr == 0) PG8_BAR; }
    PG8_BAR;
    if constexpr (Epi::AFTER_DRAIN) { E.fused(acc, cur, wr, wc, fr, fq, lds, wid, lane); S.done(cur); }
#undef PG8_SA
#undef PG8_SB
#undef PG8_STAGE
#undef PG8_LDA
#undef PG8_LDB
#undef PG8_MMA
#undef PG8_WAIT_V
#undef PG8_WAIT_L
#undef PG8_BAR
#undef PG8_SCHED
}
}

#ifndef PG8_SP2
#define PG8_SP2 true
#endif
#ifndef PG8_ALIGN
#define PG8_ALIGN true
#endif
#define GAS __attribute__((address_space(1)))
#define LAS __attribute__((address_space(3)))
typedef unsigned short bf16;
typedef unsigned v4u __attribute__((ext_vector_type(4)));
typedef float f32x4 __attribute__((ext_vector_type(4)));
typedef short bf16x8 __attribute__((ext_vector_type(8)));
typedef GAS unsigned gu32;
typedef GAS unsigned long long gu64;
#define RLX_AGENT __ATOMIC_RELAXED, __HIP_MEMORY_SCOPE_AGENT
#define LDS_WAIT() asm volatile("s_waitcnt lgkmcnt(0)" ::: "memory")
#define VM_WAIT() asm volatile("s_waitcnt vmcnt(0)" ::: "memory")
__device__ __forceinline__ unsigned long long rt() { return __builtin_amdgcn_s_memrealtime(); }
__device__ __forceinline__ unsigned f2bf(float f) { unsigned u = __builtin_bit_cast(unsigned, f); return (u + 0x7fffu + ((u >> 16) & 1u)) >> 16; }
__device__ __forceinline__ unsigned pk2(float lo, float hi) { return f2bf(lo) | (f2bf(hi) << 16); }

#define XB_TMO      128
#define XB_XCNT(j)  (256  + 64 * (j))
#define XB_XSUB(j)  (1280 + 64 * (j))
#define XB_XGEN(j)  (2304 + 64 * (j))
#define XB_TOP      3328
#define XB_TOPGEN   3392
#define XCD_BAR_WORDS 3456
#define XB_SPIN_CAP (1u << 22)

__device__ __forceinline__ unsigned xb_ld(unsigned* p)              { return __hip_atomic_load(p, __ATOMIC_RELAXED, __HIP_MEMORY_SCOPE_AGENT); }
__device__ __forceinline__ unsigned xb_add(unsigned* p, unsigned v) { return __hip_atomic_fetch_add(p, v, __ATOMIC_RELAXED, __HIP_MEMORY_SCOPE_AGENT); }
__device__ __forceinline__ unsigned xb_xcc_id() { return (unsigned)__builtin_amdgcn_s_getreg((3 << 11) | 20) & 0xFu; }
#define XB_SPIN(cond, bar) do { unsigned _sp = 0; while (cond) { __builtin_amdgcn_s_sleep(1); \
    if ((++_sp & 255u) == 0u) { if (xb_ld(&(bar)[XB_TMO])) break; if (_sp > XB_SPIN_CAP) { atomicAdd(&(bar)[XB_TMO], 1u); break; } } } } while (0)

struct XcdBarrier {
    unsigned* bar; unsigned x;
    volatile LAS unsigned* st;
};

__device__ __forceinline__ XcdBarrier xcd_barrier_post(unsigned* bar, volatile LAS unsigned* st) {
    XcdBarrier b; b.bar = bar; b.x = xb_xcc_id(); b.st = st;
    if (threadIdx.x == 0) (void)xb_add(&bar[XB_XCNT(b.x)], 1u);
    return b;
}
__device__ __forceinline__ void xcd_barrier_complete(unsigned* bar, unsigned x, unsigned& nloc, unsigned& nx) {
    const unsigned G = gridDim.x * gridDim.y * gridDim.z;
    unsigned sum, cnt, mine, sp = 0u;
    for (;;) {
        sum = 0u; cnt = 0u; mine = 0u;
#pragma unroll
        for (unsigned j = 0; j < 16; ++j) { const unsigned c = xb_ld(&bar[XB_XCNT(j)]); sum += c; cnt += (c > 0u) ? 1u : 0u; mine = (j == x) ? c : mine; }
        if (sum == G) break;
        __builtin_amdgcn_s_sleep(1);
        if ((++sp & 255u) == 0u) { if (xb_ld(&bar[XB_TMO])) break; if (sp > XB_SPIN_CAP) { atomicAdd(&bar[XB_TMO], 1u); break; } }
    }
    nloc = mine > 0u ? mine : 1u; nx = cnt > 0u ? cnt : 1u;
}

__device__ __forceinline__ void xcd_barrier(const XcdBarrier& b) {
    asm volatile("s_waitcnt vmcnt(0)" ::: "memory");
    __syncthreads();
    if (threadIdx.x == 0) {
        unsigned* bar = b.bar;
        __builtin_amdgcn_s_waitcnt(0);
        unsigned nloc = b.st[0], nx = b.st[1];
        if (nloc == 0u) { xcd_barrier_complete(bar, b.x, nloc, nx); b.st[0] = nloc; b.st[1] = nx; }
        const unsigned old = xb_add(&bar[XB_XSUB(b.x)], 1u);
        const unsigned gen = old / nloc;
        if (old + 1u == (gen + 1u) * nloc) {
            __builtin_amdgcn_fence(__ATOMIC_RELEASE, "agent");
            asm volatile("s_waitcnt vmcnt(0)" ::: "memory");
            const unsigned og = xb_add(&bar[XB_TOP], 1u);
            const unsigned tg = og / nx;
            if (og + 1u == (tg + 1u) * nx) xb_add(&bar[XB_TOPGEN], 1u);
            else XB_SPIN(xb_ld(&bar[XB_TOPGEN]) == tg, bar);
            __builtin_amdgcn_fence(__ATOMIC_ACQUIRE, "agent");
            xb_add(&bar[XB_XGEN(b.x)], 1u);
            asm volatile("s_waitcnt vmcnt(0)" ::: "memory");
        } else {
            XB_SPIN(xb_ld(&bar[XB_XGEN(b.x)]) == gen, bar);
            __builtin_amdgcn_fence(__ATOMIC_ACQUIRE, "agent");
            asm volatile("s_waitcnt vmcnt(0)" ::: "memory");
        }
    }
    __syncthreads();
}
constexpr int NWAVES = 8;
constexpr int BATCH = 4, T = 4096, D = 1024, M = BATCH * T;
constexpr int RW_W = 512, RW_COLS = 2304, HG_COLS = 2560, IN_COLS = 4864;
constexpr size_t MiB = 1u << 20;
constexpr size_t WS_CTL = 0, CTL_ZERO_BYTES = 1 * MiB;
constexpr size_t WS_P = 1 * MiB;
constexpr size_t WS_XN = 153 * MiB;
constexpr size_t WS_WIN = 185 * MiB;
constexpr size_t WS_WOUT = 249 * MiB;
constexpr size_t WS_BON = 251 * MiB;
constexpr size_t WS_W2T = 252 * MiB;
constexpr size_t WS_A2T = 252 * MiB + 131072;
constexpr size_t WS_OHG = 153 * MiB;
constexpr size_t WS_Q = 185 * MiB;
constexpr size_t WS_Y = 217 * MiB;
constexpr size_t WS_END = 256 * MiB;
constexpr int CW_TMO = 0, CW_CODE = 1, CW_BAR = 4096;
constexpr int RING_OFF = 0, RING_BYTES = 143360;
constexpr int LDSCTL_OFF = RING_BYTES, MISC_OFF = LDSCTL_OFF + 320;
constexpr int LDS_BYTES = 147456;
__device__ __forceinline__ float wave_sum(float v) {
#pragma unroll
    for (int o = 1; o < 64; o <<= 1) v += __shfl_xor(v, o);
    return v;
}
__device__ __forceinline__ void p0_transpose_item(const float* W, int K, int N, bf16* WT, LAS float* scr, int item, int lane) {
    const int nblk = N / 32, kb = item / nblk, nb = item % nblk, k0 = 64 * kb, n0 = 32 * nb;
#pragma unroll 8
    for (int i = 0; i < 32; ++i) { const int kk = 2 * i + (lane >> 5); scr[kk * 33 + (lane & 31)] = W[(size_t)(k0 + kk) * N + n0 + (lane & 31)]; }
    LDS_WAIT(); asm volatile("" ::: "memory");
    const int c = lane & 7;
#pragma unroll
    for (int j = 0; j < 4; ++j) { const int n = (lane >> 3) + 8 * j; const LAS float* s = scr + (8 * c) * 33 + n;
        v4u o; o.x = pk2(s[0 * 33], s[1 * 33]); o.y = pk2(s[2 * 33], s[3 * 33]); o.z = pk2(s[4 * 33], s[5 * 33]); o.w = pk2(s[6 * 33], s[7 * 33]);
        *(GAS v4u*)(WT + (size_t)(n0 + n) * K + k0 + 8 * c) = o; }
    LDS_WAIT(); asm volatile("" ::: "memory");
}
__device__ __forceinline__ void rms_row_to_bf16(const float* xrow, const float* g, bf16* orow, int lane) {
    const GAS f32x4* xr = (const GAS f32x4*)xrow + lane;
    const GAS f32x4* gr = (const GAS f32x4*)g + lane;
    f32x4 v[4]; float s = 0.f;
#pragma unroll
    for (int j = 0; j < 4; ++j) { v[j] = xr[64 * j]; s += (v[j].x * v[j].x + v[j].y * v[j].y) + (v[j].z * v[j].z + v[j].w * v[j].w); }
    const float rstd = 1.f / sqrtf(wave_sum(s) * (1.f / D) + 1e-6f);
    GAS unsigned long long* o8 = (GAS unsigned long long*)orow + lane;
#pragma unroll
    for (int j = 0; j < 4; ++j) { const f32x4 gv = gr[64 * j];
        o8[64 * j] = (unsigned long long)pk2(v[j].x * rstd * gv.x, v[j].y * rstd * gv.y) | ((unsigned long long)pk2(v[j].z * rstd * gv.z, v[j].w * rstd * gv.w) << 32); }
}

__device__ __forceinline__ float bfu(bf16 b) { return __uint_as_float(((unsigned)b) << 16); }
__device__ __forceinline__ float shifted_tok(const bf16* __restrict__ p, int b, int t, int c, float mup, float mun) {
    const size_t row = (size_t)b * T + t;
    const float cur = bfu(p[row * IN_COLS + c]);
    const float prv = t > 0 ? bfu(p[(row - 1) * IN_COLS + c]) : 0.f;
    const float nxt = t < T - 1 ? bfu(p[(row + 1) * IN_COLS + c]) : 0.f;
    return cur + mup * (prv - cur) + mun * (nxt - cur);
}
__device__ __forceinline__ float sigmoidf_(float v) { return 1.0f / (1.0f + __expf(-v)); }

__device__ __forceinline__ void hg_scan_naive(const bf16* __restrict__ p, const float* __restrict__ lb_logits, bf16* __restrict__ o_out, LAS float* sm, int item, int lane) {
    const int vq = item & 3, h = (item >> 2) & 3, b = (item >> 4) & 3, d = item >> 6;
    const int ck0 = h * 128 + lane, ck1 = ck0 + 64, cv = h * 128 + vq * 32 + (lane >> 1), k0 = (lane & 1) * 64;
    const float lb0 = sigmoidf_(lb_logits[ck0] - lb_logits[512 + ck0]), lb1 = sigmoidf_(lb_logits[ck1] - lb_logits[512 + ck1]);
    float S[64];
#pragma unroll
    for (int j = 0; j < 64; ++j) S[j] = 0.f;
    for (int s = 0; s < T; ++s) {
        const int t = d ? (T - 1 - s) : s;
        const size_t row = (size_t)b * T + t;
        const bf16* pr = p + row * IN_COLS + RW_COLS;
        const float q0 = bfu(pr[ck0]), q1 = bfu(pr[ck1]);
        const float z0 = bfu(pr[512 + d * 512 + ck0]), z1 = bfu(pr[512 + d * 512 + ck1]);
        const float iv = bfu(pr[1536 + cv]);
        __builtin_amdgcn_wave_barrier();
        sm[lane] = lb0 + (1.0f - lb0) / (1.0f + expf(-z0)); sm[64 + lane] = lb1 + (1.0f - lb1) / (1.0f + expf(-z1));
        sm[128 + lane] = q0; sm[192 + lane] = q1;
        __builtin_amdgcn_wave_barrier();
        float o = 0.f;
#pragma unroll
        for (int k = 0; k < 64; ++k) { const float fk = sm[k0 + k]; S[k] = fk * S[k] + (1.0f - fk) * iv; o += sm[128 + k0 + k] * S[k]; }
        o += __shfl_xor(o, 1);
        if ((lane & 1) == 0) o_out[((size_t)d * M + row) * 512 + cv] = (bf16)f2bf(o);
    }
}
__device__ __forceinline__ void mix_row(const bf16* __restrict__ p, const float* const* in, const bf16* __restrict__ Yarr, const float* __restrict__ bonus, const bf16* __restrict__ o_hg, bf16* __restrict__ ymix, int row, int lane) {
    const float* mu_prev = in[3]; const float* mu_next = in[4]; const float* ln_w = in[12]; const float* ln_b = in[13]; const float* norm_g = in[15];
    const int b = row / T, t = row % T;
#pragma unroll 2
    for (int i = 0; i < 8; ++i) {
        const int c = i * 64 + lane;
        const size_t itf = ((size_t)((0 * 4 + b) * 8 + i)) * 64 + (t >> 6), itb = ((size_t)((1 * 4 + b) * 8 + i)) * 64 + (63 - (t >> 6));
        const float y = bfu(Yarr[itf * 4096 + (t & 63) * 64 + lane]) + bfu(Yarr[itb * 4096 + (63 - (t & 63)) * 64 + lane]);
        const float mu = wave_sum(y) * (1.0f / 64.0f);
        const float dlt = y - mu;
        const float var = wave_sum(dlt * dlt) * (1.0f / 64.0f);
        float yn = dlt * (1.0f / sqrtf(var + 64e-5f)) * ln_w[c] + ln_b[c];
        const float vs = shifted_tok(p, b, t, 1024 + c, mu_prev[1024 + c], mu_next[1024 + c]);
        const float gs = shifted_tok(p, b, t, 1536 + c, mu_prev[1536 + c], mu_next[1536 + c]);
        const float bo = bonus[(size_t)row * 8 + i] + bonus[((size_t)M + row) * 8 + i];
        yn += bo * vs;
        ymix[(size_t)row * 1024 + c] = (bf16)f2bf(yn * gs * sigmoidf_(gs));
    }
#pragma unroll
    for (int hh = 0; hh < 4; ++hh) {
        const int c0 = hh * 128 + lane, c1 = c0 + 64;
        const float o0 = bfu(o_hg[(size_t)row * 512 + c0]) + bfu(o_hg[((size_t)M + row) * 512 + c0]);
        const float o1 = bfu(o_hg[(size_t)row * 512 + c1]) + bfu(o_hg[((size_t)M + row) * 512 + c1]);
        const float rstd = 1.0f / sqrtf(wave_sum(o0 * o0 + o1 * o1) * (1.0f / 128.0f) + 1e-6f);
        const float g0 = bfu(p[(size_t)row * IN_COLS + RW_COLS + 2048 + c0]), g1 = bfu(p[(size_t)row * IN_COLS + RW_COLS + 2048 + c1]);
        ymix[(size_t)row * 1024 + 512 + c0] = (bf16)f2bf(o0 * rstd * norm_g[lane] * g0 * sigmoidf_(g0));
        ymix[(size_t)row * 1024 + 512 + c1] = (bf16)f2bf(o1 * rstd * norm_g[64 + lane] * g1 * sigmoidf_(g1));
    }
}
__device__ __forceinline__ void post_row(const float* xrow, const float* yrow, const float* g, float* orow, int lane) {
    const GAS f32x4* yr = (const GAS f32x4*)yrow + lane; const GAS f32x4* xr = (const GAS f32x4*)xrow + lane; const GAS f32x4* gr = (const GAS f32x4*)g + lane;
    f32x4 v[4]; float s = 0.f;
#pragma unroll
    for (int j = 0; j < 4; ++j) { v[j] = yr[64 * j]; s += (v[j].x * v[j].x + v[j].y * v[j].y) + (v[j].z * v[j].z + v[j].w * v[j].w); }
    const float rstd = 1.f / sqrtf(wave_sum(s) * (1.f / D) + 1e-6f);
    GAS f32x4* o4 = (GAS f32x4*)orow + lane;
#pragma unroll
    for (int j = 0; j < 4; ++j) o4[64 * j] = xr[64 * j] + v[j] * rstd * gr[64 * j];
}
typedef unsigned v2u __attribute__((ext_vector_type(2)));
__device__ __forceinline__ f32x4 mfma16(bf16x8 a, bf16x8 b, f32x4 c) { return __builtin_amdgcn_mfma_f32_16x16x32_bf16(a, b, c, 0, 0, 0); }
constexpr int MS = 144;
constexpr int MB = 64 * MS;
constexpr int A_LWO = 0, A_LAO = 16384;
constexpr int A_LQ = 0, A_PKK = 16384;
constexpr int A_TW = 32768, A_AD = 32768 + MB;
constexpr int A_WP = 32768;
constexpr int A_KKT = 51200, A_RT = A_KKT + MB, A_KH = A_RT + MB, A_BH = A_KH + MB, A_KHT = A_BH + MB, A_BHT = A_KHT + MB, A_VT = A_BHT + MB;
constexpr int A_XT = A_KH;
constexpr int A_PRB = A_VT + MB, A_PRK = A_PRB + MB;
constexpr int A_EC = A_PRK + MB, A_SEG = A_EC + 256, A_END = A_SEG + 2048;
static_assert(A_VT + MB == 115712 && A_END <= 143360, "2a LDS map");
constexpr int WPS = 72;

__device__ __forceinline__ bf16x8 ldsfrag(LAS const unsigned char* base, int row0, int k0, int lane) {
    return *(const LAS bf16x8*)(base + (row0 + (lane & 15)) * MS + (k0 + 8 * (lane >> 4)) * 2);
}
template <int CTRL> __device__ __forceinline__ float dppx(float x) { return __int_as_float(__builtin_amdgcn_update_dpp(0, __float_as_int(x), CTRL, 0xF, 0xF, true)); }
__device__ __forceinline__ float wsum(float x) {
    x += dppx<0xB1>(x); x += dppx<0x4E>(x); x += dppx<0x141>(x); x += dppx<0x140>(x);
    const int xi = __float_as_int(x);
    const float a = __int_as_float(__builtin_amdgcn_readlane(xi, 0)), b = __int_as_float(__builtin_amdgcn_readlane(xi, 16)), c = __int_as_float(__builtin_amdgcn_readlane(xi, 32)), d = __int_as_float(__builtin_amdgcn_readlane(xi, 48));
    return (a + b) + (c + d);
}
__device__ __forceinline__ float quad_sum(float x) { x += dppx<0xB1>(x); x += dppx<0x4E>(x); return x; }
typedef __bf16 bf16x2_t __attribute__((ext_vector_type(2)));
typedef float f32x2_t __attribute__((ext_vector_type(2)));
__device__ __forceinline__ unsigned pkbf(float lo, float hi) { f32x2_t v = {lo, hi}; bf16x2_t b = __builtin_convertvector(v, bf16x2_t); return __builtin_bit_cast(unsigned, b); }
__device__ __forceinline__ bf16 bf1(float v) { return (bf16)(pkbf(v, 0.f) & 0xffffu); }

__device__ __forceinline__ void rw2a_item(LAS unsigned char* lds, const bf16* __restrict__ P, const float* const* in, const bf16* __restrict__ W2T, const bf16* __restrict__ A2T,
                                          bf16* __restrict__ Marr, bf16* __restrict__ Narr, bf16* __restrict__ Qarr, bf16* __restrict__ Yarr, float* __restrict__ BON,
                                          int b, int h, int c, int tid, int lane, int wave) {
    const float* mu_prev = in[3]; const float* mu_next = in[4];
    const int g = lane >> 4, l15 = lane & 15;
    const size_t rowbase = (size_t)b * T + (size_t)c * 64;
#pragma unroll 1
    for (int d = 0; d < 2; ++d) {
        const int cs = d ? 63 - c : c;
        const size_t item = ((size_t)((d * 4 + b) * 8 + h)) * 64 + cs;
        {
            const int tau = tid >> 3, cg = tid & 7;
            const int t = c * 64 + tau;
#pragma unroll
            for (int arr = 0; arr < 2; ++arr) {
                const int col0 = (arr == 0 ? 2048 : 2176) + d * 64 + 8 * cg;
                const bf16* pr = P + (rowbase + tau) * IN_COLS + col0;
                const v4u cur = *(const v4u*)pr;
                v4u prv = (v4u){0u, 0u, 0u, 0u}, nxt = (v4u){0u, 0u, 0u, 0u};
                if (t > 0) prv = *(const v4u*)(pr - IN_COLS);
                if (t < T - 1) nxt = *(const v4u*)(pr + IN_COLS);
                const f32x4 mp0 = *(const f32x4*)(mu_prev + col0), mp1 = *(const f32x4*)(mu_prev + col0 + 4);
                const f32x4 mn0 = *(const f32x4*)(mu_next + col0), mn1 = *(const f32x4*)(mu_next + col0 + 4);
                float o[8];
#pragma unroll
                for (int e = 0; e < 8; ++e) {
                    const unsigned cw = cur[e >> 1], pw = prv[e >> 1], nw = nxt[e >> 1];
                    const float cv = __uint_as_float((e & 1) ? (cw & 0xffff0000u) : (cw << 16));
                    const float pv = __uint_as_float((e & 1) ? (pw & 0xffff0000u) : (pw << 16));
                    const float nv = __uint_as_float((e & 1) ? (nw & 0xffff0000u) : (nw << 16));
                    const float mp = e < 4 ? mp0[e & 3] : mp1[e & 3], mn = e < 4 ? mn0[e & 3] : mn1[e & 3];
                    float sv = cv + mp * (pv - cv) + mn * (nv - cv);
                    if (arr == 0) { const float ex = __expf(2.0f * sv); sv = 1.0f - 2.0f / (ex + 1.0f); }
                    o[e] = sv;
                }
                v4u w; w.x = pkbf(o[0], o[1]); w.y = pkbf(o[2], o[3]); w.z = pkbf(o[4], o[5]); w.w = pkbf(o[6], o[7]);
                *(LAS v4u*)(lds + (arr == 0 ? A_TW : A_AD) + tau * MS + cg * 16) = w;
            }
        }
        const int j = tid & 63, seg = tid >> 6;
        const int ch = h * 64 + j;
        unsigned short raw[3][10];
#pragma unroll
        for (int a3 = 0; a3 < 3; ++a3)
#pragma unroll
            for (int rr = 0; rr < 10; ++rr) {
                const int tau = d ? (64 - 8 * seg - rr) : (8 * seg - 1 + rr); const int t = c * 64 + tau;
                raw[a3][rr] = (t >= 0 && t < T) ? P[(size_t)((long)rowbase + tau) * IN_COLS + a3 * 512 + ch] : (unsigned short)0;
            }
        __syncthreads();
        {
            const int p = wave >> 2, tt = wave & 3;
            const bf16* WT = (p == 0 ? W2T : A2T) + ((size_t)d * 512 + h * 64) * 64;
            const bf16x8 a0 = ldsfrag(lds + (p == 0 ? A_TW : A_AD), 16 * tt, 0, lane), a1 = ldsfrag(lds + (p == 0 ? A_TW : A_AD), 16 * tt, 32, lane);
#pragma unroll
            for (int jt = 0; jt < 4; ++jt) {
                const bf16* bp = WT + (size_t)(16 * jt + l15) * 64 + 8 * g;
                const bf16x8 b0 = *(const bf16x8*)bp, b1 = *(const bf16x8*)(bp + 32);
                f32x4 acc = (f32x4){0.f, 0.f, 0.f, 0.f};
                acc = mfma16(a0, b0, acc); acc = mfma16(a1, b1, acc);
                LAS float* o = (LAS float*)(lds + (p == 0 ? A_LWO : A_LAO)) + (16 * tt + 4 * g) * 64 + 16 * jt + l15;
#pragma unroll
                for (int rg = 0; rg < 4; ++rg) o[rg * 64] = acc[rg];
            }
        }
        __syncthreads();
        float lw[8], cl[8];
        {
            const float w0c = in[5][d * 512 + ch];
            float run = 0.f;
#pragma unroll
            for (int i = 0; i < 8; ++i) {
                const int sg = 8 * seg + i, tau = d ? 63 - sg : sg;
                const float wr = w0c + ((const LAS float*)(lds + A_LWO))[tau * 64 + j];
                lw[i] = -0.60653065971f / (1.0f + __expf(-wr));
                run += lw[i]; cl[i] = run;
            }
            ((LAS float*)(lds + A_SEG))[seg * 64 + j] = run;
        }
        __syncthreads();
        float off = 0.f, ctot = 0.f;
#pragma unroll
        for (int s8 = 0; s8 < 8; ++s8) { const float v = ((const LAS float*)(lds + A_SEG))[s8 * 64 + j]; if (s8 < seg) off += v; ctot += v; }
        if (seg == 7) ((LAS float*)(lds + A_EC))[j] = __expf(ctot);
        {
            const float a0c = in[7][d * 512 + ch], kkc = in[9][ch], kac = in[10][ch], rkc = in[11][ch];
            const float mpr = mu_prev[ch], mnr = mu_next[ch], mpk = mu_prev[512 + ch], mnk = mu_next[512 + ch], mpv = mu_prev[1024 + ch], mnv = mu_next[1024 + ch];
            float kht[8], bht[8], vt[8];
#pragma unroll
            for (int i = 0; i < 8; ++i) {
                const int sg = 8 * seg + i, tau = d ? 63 - sg : sg;
                float sh[3];
#pragma unroll
                for (int a3 = 0; a3 < 3; ++a3) {
                    const float cv = __uint_as_float((unsigned)raw[a3][i + 1] << 16), lo_ = __uint_as_float((unsigned)raw[a3][i] << 16), hi_ = __uint_as_float((unsigned)raw[a3][i + 2] << 16);
                    const float pv = d ? hi_ : lo_, nv = d ? lo_ : hi_;
                    const float mp = a3 == 0 ? mpr : (a3 == 1 ? mpk : mpv), mn = a3 == 0 ? mnr : (a3 == 1 ? mnk : mnv);
                    sh[a3] = cv + mp * (pv - cv) + mn * (nv - cv);
                }
                const float rs = sh[0], ks = sh[1], vs = sh[2];
                const float ar = a0c + ((const LAS float*)(lds + A_LAO))[tau * 64 + j];
                const float a = 1.0f / (1.0f + __expf(-ar));
                float kkv = ks * kkc;
                const float n2 = wsum(kkv * kkv);
                kkv = kkv / fmaxf(sqrtf(n2), 1e-12f);
                const float kd = ks * (1.0f + (a - 1.0f) * kac);
                const float bb = kkv * a;
                const float bo = wsum(rs * kd * rkc);
                if (lane == 0) BON[((size_t)d * M + rowbase + tau) * 8 + h] = bo;
                const float cs_ = off + cl[i];
                const float E = __expf(cs_), Ep = __expf(cs_ - lw[i]), Ei = __expf(-cs_);
                const int o2 = sg * MS + 2 * j;
                *(LAS bf16*)(lds + A_KKT + o2) = bf1(kkv * Ep);
                *(LAS bf16*)(lds + A_RT + o2) = bf1(rs * E);
                const float khv = kd * Ei, bhv = bb * Ei;
                *(LAS bf16*)(lds + A_KH + o2) = bf1(khv);
                *(LAS bf16*)(lds + A_BH + o2) = bf1(bhv);
                kht[i] = khv; bht[i] = bhv; vt[i] = vs;
            }
            v4u w;
            w.x = pkbf(kht[0], kht[1]); w.y = pkbf(kht[2], kht[3]); w.z = pkbf(kht[4], kht[5]); w.w = pkbf(kht[6], kht[7]);
            *(LAS v4u*)(lds + A_KHT + j * MS + seg * 16) = w;
            w.x = pkbf(bht[0], bht[1]); w.y = pkbf(bht[2], bht[3]); w.z = pkbf(bht[4], bht[5]); w.w = pkbf(bht[6], bht[7]);
            *(LAS v4u*)(lds + A_BHT + j * MS + seg * 16) = w;
            w.x = pkbf(vt[0], vt[1]); w.y = pkbf(vt[2], vt[3]); w.z = pkbf(vt[4], vt[5]); w.w = pkbf(vt[6], vt[7]);
            *(LAS v4u*)(lds + A_VT + j * MS + seg * 16) = w;
        }
        __syncthreads();
        {
            const int p = wave >> 1;
            const int tside = (p < 2) ? A_KKT : A_RT, sside = (p == 0 || p == 2) ? A_BH : A_KH;
            const int pout = (p == 1) ? A_PKK : (p == 2 ? A_PRB : A_PRK);
#pragma unroll
            for (int q2 = 0; q2 < 2; ++q2) {
                const int tt = (wave & 1) ? (1 + q2) : (3 * q2);
                const bf16x8 t0 = ldsfrag(lds + tside, 16 * tt, 0, lane), t1 = ldsfrag(lds + tside, 16 * tt, 32, lane);
                for (int st = 0; st <= tt; ++st) {
                    const bf16x8 s0 = ldsfrag(lds + sside, 16 * st, 0, lane), s1 = ldsfrag(lds + sside, 16 * st, 32, lane);
                    f32x4 acc = (f32x4){0.f, 0.f, 0.f, 0.f};
                    if (p == 0) {
                        acc = mfma16(t0, s0, acc); acc = mfma16(t1, s1, acc);
                        const int s = 16 * st + l15;
#pragma unroll
                        for (int rg = 0; rg < 4; ++rg) { const int t = 16 * tt + 4 * g + rg;
                            ((LAS float*)(lds + A_LQ))[t * 64 + (s & 3) * 16 + (s >> 2)] = (s < t) ? acc[rg] : 0.f; }
                    } else {
                        acc = mfma16(s0, t0, acc); acc = mfma16(s1, t1, acc);
                        const int t = 16 * tt + l15, sb = 16 * st + 4 * g;
                        float m[4];
#pragma unroll
                        for (int rg = 0; rg < 4; ++rg) { const int s = sb + rg; const bool keep = (p == 1) ? (s < t) : (s <= t); m[rg] = keep ? acc[rg] : 0.f; }
                        v2u w; w.x = pkbf(m[0], m[1]); w.y = pkbf(m[2], m[3]);
                        *(LAS v2u*)(lds + pout + t * MS + sb * 2) = w;
                    }
                }
                if (p != 0 && (tt == 0 || tt == 2)) {
                    *(LAS v2u*)(lds + pout + (16 * tt + l15) * MS + (16 * (tt + 1) + 4 * g) * 2) = (v2u){0u, 0u};
                }
            }
        }
        __syncthreads();
        {
            const int tt = wave >> 1;
#pragma unroll
            for (int q2 = 0; q2 < 2; ++q2) {
                const int vtile = 2 * (wave & 1) + q2;
                f32x4 acc = (f32x4){0.f, 0.f, 0.f, 0.f};
                acc = mfma16(ldsfrag(lds + A_PKK, 16 * tt, 0, lane), ldsfrag(lds + A_VT, 16 * vtile, 0, lane), acc);
                if (tt >= 2) acc = mfma16(ldsfrag(lds + A_PKK, 16 * tt, 32, lane), ldsfrag(lds + A_VT, 16 * vtile, 32, lane), acc);
                LAS float* o = (LAS float*)(lds + A_WP) + (16 * tt + 4 * g) * WPS + 16 * vtile + l15;
#pragma unroll
                for (int rg = 0; rg < 4; ++rg) o[rg * WPS] = acc[rg];
            }
        }
        __syncthreads();
        float X[16];
        {
            const int col = tid >> 2, q = tid & 3;
            float R[16];
#pragma unroll
            for (int m = 0; m < 16; ++m) {
                const int t = 4 * m + q;
                R[m] = (col < 64) ? __uint_as_float((unsigned)(*(const LAS bf16*)(lds + A_KKT + t * MS + col * 2)) << 16)
                                  : ((const LAS float*)(lds + A_WP))[t * WPS + (col - 64)];
                X[m] = 0.f;
            }
            const LAS float* Lq = (const LAS float*)(lds + A_LQ) + q * 16;
#pragma unroll
            for (int t = 0; t < 64; ++t) {
                float part = ((t & 3) == q) ? R[t >> 2] : 0.f;
                const int nm = (t + 3) >> 2;
#pragma unroll
                for (int m4 = 0; m4 < (nm + 3) / 4; ++m4) {
                    const f32x4 lv = *(const LAS f32x4*)(Lq + t * 64 + 4 * m4);
#pragma unroll
                    for (int e = 0; e < 4; ++e) if (4 * m4 + e < nm) part -= lv[e] * X[4 * m4 + e];
                }
                const float tot = quad_sum(part);
                X[t >> 2] = ((t & 3) == q) ? tot : X[t >> 2];
            }
        }
        __syncthreads();
        {
            const int col = tid >> 2, q = tid & 3;
#pragma unroll
            for (int m = 0; m < 16; ++m) *(LAS bf16*)(lds + A_XT + col * MS + (4 * m + q) * 2) = bf1(-X[m]);
        }
        __syncthreads();
        {
            const float* ECp = nullptr; (void)ECp;
            bf16* Mo = Marr + item * 4096; bf16* No = Narr + item * 4096; bf16* Qo = Qarr + item * 4096; bf16* Yo = Yarr + item * 4096;
#pragma unroll
            for (int q2 = 0; q2 < 2; ++q2) {
                const int e = 2 * wave + q2, ra = e >> 2, cb = e & 3;
                {
                    f32x4 acc = (f32x4){0.f, 0.f, 0.f, 0.f};
                    acc = mfma16(ldsfrag(lds + A_XT, 16 * ra, 0, lane), ldsfrag(lds + A_PRB, 16 * cb, 0, lane), acc);
                    if (cb >= 2) acc = mfma16(ldsfrag(lds + A_XT, 16 * ra, 32, lane), ldsfrag(lds + A_PRB, 16 * cb, 32, lane), acc);
                    const int t = 16 * cb + l15, jb = 16 * ra + 4 * g;
                    const v2u rw = *(const LAS v2u*)(lds + A_RT + t * MS + jb * 2);
                    const float r0 = __uint_as_float(rw.x << 16), r1 = __uint_as_float(rw.x & 0xffff0000u), r2 = __uint_as_float(rw.y << 16), r3 = __uint_as_float(rw.y & 0xffff0000u);
                    v2u w; w.x = pkbf(r0 + acc[0], r1 + acc[1]); w.y = pkbf(r2 + acc[2], r3 + acc[3]);
                    *(v2u*)(Qo + t * 64 + jb) = w;
                }
                {
                    f32x4 acc = (f32x4){0.f, 0.f, 0.f, 0.f};
                    acc = mfma16(ldsfrag(lds + A_VT, 16 * ra, 0, lane), ldsfrag(lds + A_PRK, 16 * cb, 0, lane), acc);
                    acc = mfma16(ldsfrag(lds + A_XT, 64 + 16 * ra, 0, lane), ldsfrag(lds + A_PRB, 16 * cb, 0, lane), acc);
                    if (cb >= 2) {
                        acc = mfma16(ldsfrag(lds + A_VT, 16 * ra, 32, lane), ldsfrag(lds + A_PRK, 16 * cb, 32, lane), acc);
                        acc = mfma16(ldsfrag(lds + A_XT, 64 + 16 * ra, 32, lane), ldsfrag(lds + A_PRB, 16 * cb, 32, lane), acc);
                    }
                    const int t = 16 * cb + l15, vb = 16 * ra + 4 * g;
                    v2u w; w.x = pkbf(acc[0], acc[1]); w.y = pkbf(acc[2], acc[3]);
                    *(v2u*)(Yo + t * 64 + vb) = w;
                }
                {
                    f32x4 acc = (f32x4){0.f, 0.f, 0.f, 0.f};
                    acc = mfma16(ldsfrag(lds + A_XT, 16 * ra, 0, lane), ldsfrag(lds + A_BHT, 16 * cb, 0, lane), acc);
                    acc = mfma16(ldsfrag(lds + A_XT, 16 * ra, 32, lane), ldsfrag(lds + A_BHT, 16 * cb, 32, lane), acc);
                    const int jj = 16 * cb + l15, jpb = 16 * ra + 4 * g;
                    const float ec = ((const LAS float*)(lds + A_EC))[jj];
                    float m[4];
#pragma unroll
                    for (int rg = 0; rg < 4; ++rg) m[rg] = ec * (((jpb + rg) == jj ? 1.0f : 0.0f) + acc[rg]);
                    v2u w; w.x = pkbf(m[0], m[1]); w.y = pkbf(m[2], m[3]);
                    *(v2u*)(Mo + jj * 64 + jpb) = w;
                }
                {
                    f32x4 acc = (f32x4){0.f, 0.f, 0.f, 0.f};
#pragma unroll
                    for (int ks = 0; ks < 2; ++ks) {
                        acc = mfma16(ldsfrag(lds + A_KHT, 16 * ra, 32 * ks, lane), ldsfrag(lds + A_VT, 16 * cb, 32 * ks, lane), acc);
                        acc = mfma16(ldsfrag(lds + A_BHT, 16 * ra, 32 * ks, lane), ldsfrag(lds + A_XT, 64 + 16 * cb, 32 * ks, lane), acc);
                    }
                    const int v = 16 * cb + l15, jb = 16 * ra + 4 * g;
                    const f32x4 ec = *(const LAS f32x4*)((const LAS float*)(lds + A_EC) + jb);
                    v2u w; w.x = pkbf(ec[0] * acc[0], ec[1] * acc[1]); w.y = pkbf(ec[2] * acc[2], ec[3] * acc[3]);
                    *(v2u*)(No + v * 64 + jb) = w;
                }
            }
        }
        __syncthreads();
    }
}

__device__ __forceinline__ void rw2b_seq(LAS unsigned char* lds, const bf16* __restrict__ Marr, const bf16* __restrict__ Narr, const bf16* __restrict__ Qarr, bf16* __restrict__ Yarr,
                                         int seq, int vh, int tid, int lane, int wave) {
    const int g = lane >> 4, l15 = lane & 15;
    const int vt = wave & 1, rt = wave >> 1;
    constexpr int HB = 32 * MS;
    for (int u = tid; u < 2 * HB / 4; u += NWAVES * 64) ((LAS unsigned*)lds)[u] = 0u;
    __syncthreads();
    const size_t it0 = (size_t)seq * 64;
    const int offQ = (16 * rt + l15) * 64 + 8 * g;
    const int offY = (16 * rt + l15) * 64 + 32 * vh + 16 * vt + 4 * g;
    const int offN = (32 * vh + 16 * vt + l15) * 64 + 16 * rt + 4 * g;
    bf16x8 q0 = *(const bf16x8*)(Qarr + it0 * 4096 + offQ), q1 = *(const bf16x8*)(Qarr + it0 * 4096 + offQ + 32);
    bf16x8 m0 = *(const bf16x8*)(Marr + it0 * 4096 + offQ), m1 = *(const bf16x8*)(Marr + it0 * 4096 + offQ + 32);
    v2u yl = *(const v2u*)(Yarr + it0 * 4096 + offY), nl = *(const v2u*)(Narr + it0 * 4096 + offN);
    int cur = 0;
#pragma unroll 1
    for (int cs = 0; cs < 64; ++cs) {
        const size_t itn = it0 + (cs < 63 ? cs + 1 : cs);
        const bf16x8 nq0 = *(const bf16x8*)(Qarr + itn * 4096 + offQ), nq1 = *(const bf16x8*)(Qarr + itn * 4096 + offQ + 32);
        const bf16x8 nm0 = *(const bf16x8*)(Marr + itn * 4096 + offQ), nm1 = *(const bf16x8*)(Marr + itn * 4096 + offQ + 32);
        const v2u nyl = *(const v2u*)(Yarr + itn * 4096 + offY), nnl = *(const v2u*)(Narr + itn * 4096 + offN);
        const LAS unsigned char* hb = lds + cur * HB;
        const bf16x8 h0 = ldsfrag(hb, 16 * vt, 0, lane), h1 = ldsfrag(hb, 16 * vt, 32, lane);
        f32x4 ya; ya[0] = __uint_as_float(yl.x << 16); ya[1] = __uint_as_float(yl.x & 0xffff0000u); ya[2] = __uint_as_float(yl.y << 16); ya[3] = __uint_as_float(yl.y & 0xffff0000u);
        ya = mfma16(h0, q0, ya); ya = mfma16(h1, q1, ya);
        f32x4 ha; ha[0] = __uint_as_float(nl.x << 16); ha[1] = __uint_as_float(nl.x & 0xffff0000u); ha[2] = __uint_as_float(nl.y << 16); ha[3] = __uint_as_float(nl.y & 0xffff0000u);
        ha = mfma16(m0, h0, ha); ha = mfma16(m1, h1, ha);
        { v2u w; w.x = pkbf(ya[0], ya[1]); w.y = pkbf(ya[2], ya[3]); *(v2u*)(Yarr + (it0 + cs) * 4096 + offY) = w; }
        { v2u w; w.x = pkbf(ha[0], ha[1]); w.y = pkbf(ha[2], ha[3]); *(LAS v2u*)(lds + (cur ^ 1) * HB + (16 * vt + l15) * MS + (16 * rt + 4 * g) * 2) = w; }
        __syncthreads();
        cur ^= 1; q0 = nq0; q1 = nq1; m0 = nm0; m1 = nm1; yl = nyl; nl = nnl;
    }
}
struct Args { const float* in[18]; float* out; unsigned char* ws; int ph_lo, ph_hi; };
__global__ void __launch_bounds__(NWAVES * 64, 2) mega(Args args) {
    extern __shared__ __attribute__((aligned(16))) unsigned char lds_raw[];
    LAS unsigned char* lds = (LAS unsigned char*)lds_raw;
    volatile LAS unsigned* MISC = (volatile LAS unsigned*)(lds + MISC_OFF);
    const int tid = threadIdx.x, lane = tid & 63, wave = __builtin_amdgcn_readfirstlane(tid >> 6);
    const int G = gridDim.x;
    const int vcu = (G % 8 == 0) ? ((int)blockIdx.x % 8) * (G / 8) + (int)blockIdx.x / 8 : (int)blockIdx.x;
    unsigned char* ws = args.ws;
    gu32* ctl = (gu32*)(ws + WS_CTL);
    for (int u = tid; u < (LDS_BYTES - LDSCTL_OFF) / 4; u += NWAVES * 64) ((LAS unsigned*)(lds + LDSCTL_OFF))[u] = 0u;
    __syncthreads();
    XcdBarrier bar = xcd_barrier_post((unsigned*)(ctl + CW_BAR), MISC + 8);
    const int lo = args.ph_lo, hi = args.ph_hi;
#define IN(k) (lo <= (k) && (k) < hi)
#define BOTH(k) (IN(k) && IN((k) + 1))
    const float* x = args.in[0]; const float* pre_g = args.in[1]; const float* w_in = args.in[2]; const float* w_out = args.in[16];
    bf16* P = (bf16*)(ws + WS_P); bf16* XN = (bf16*)(ws + WS_XN); bf16* WIN_T = (bf16*)(ws + WS_WIN); bf16* WOUT_T = (bf16*)(ws + WS_WOUT); bf16* W2T = (bf16*)(ws + WS_W2T); bf16* A2T = (bf16*)(ws + WS_A2T);
    bf16* Marr = (bf16*)args.out; bf16* Narr = (bf16*)args.out + (size_t)16 * 1024 * 1024; bf16* Qarr = (bf16*)(ws + WS_Q); bf16* Yarr = (bf16*)(ws + WS_Y); bf16* OHG = (bf16*)(ws + WS_OHG);

    if (IN(0)) {
        LAS float* scr = (LAS float*)(lds + RING_OFF + wave * 16384);
        const int gw = vcu * NWAVES + wave, NGW = G * NWAVES;
        constexpr int I_IN = (D / 64) * (IN_COLS / 32), I_OUT = (D / 64) * (D / 32);
        for (int it = gw; it < I_IN + I_OUT; it += NGW) {
            if (it < I_IN) p0_transpose_item(w_in, D, IN_COLS, WIN_T, scr, it, lane);
            else p0_transpose_item(w_out, D, D, WOUT_T, scr, it - I_IN, lane);
        }
        for (int it = gw; it < 64; it += NGW) {
            const int which = it >> 5, dd = (it >> 4) & 1, sub = it & 15;
            p0_transpose_item(args.in[which ? 8 : 6] + (size_t)dd * 64 * 512, 64, 512, (which ? A2T : W2T) + (size_t)dd * 512 * 64, scr, sub, lane);
        }
        for (int m = gw; m < M; m += NGW) rms_row_to_bf16(x + (size_t)m * D, pre_g, XN + (size_t)m * D, lane);
        if (BOTH(0)) xcd_barrier(bar);
    }
    if (IN(1)) {
        pg8::Gemm g{XN, WIN_T, M, IN_COLS, D}; pg8::StaticOrder S; S.init(M, IN_COLS, G, (int)blockIdx.x);
        pg8::EpiBf16<0> E{P, IN_COLS, nullptr, 0, 0, 1.f};
        pg8::gemm_phase<pg8::EpiBf16<0>, pg8::StaticOrder, PG8_ALIGN, PG8_SP2>(lds + RING_OFF, g, S, E);
        if (BOTH(1)) xcd_barrier(bar);
    }
    float* BON = (float*)(ws + WS_BON); bf16* YMIX = Qarr; float* Y = args.out;
    if (IN(2)) {
        for (int i = 0; i < 8; ++i) { const int wi = vcu * 8 + i; rw2a_item(lds, P, args.in, W2T, A2T, Marr, Narr, Qarr, Yarr, BON, wi >> 9, (wi >> 6) & 7, wi & 63, tid, lane, wave); }
        if (BOTH(2)) xcd_barrier(bar);
    }
    if (IN(3)) {
        if (vcu < 128) rw2b_seq(lds, Marr, Narr, Qarr, Yarr, vcu >> 1, vcu & 1, tid, lane, wave);
        else if (vcu < 192) { if (wave < 2) hg_scan_naive(P, args.in[14], OHG, (LAS float*)(lds + RING_OFF + wave * 4096), (vcu - 128) * 2 + wave, lane); }
        if (BOTH(3)) xcd_barrier(bar);
    }
    if (IN(4)) {
        const int gw = vcu * NWAVES + wave, NGW = G * NWAVES;
        for (int m = gw; m < M; m += NGW) mix_row(P, args.in, Yarr, BON, OHG, YMIX, m, lane);
        if (BOTH(4)) xcd_barrier(bar);
    }
    if (IN(5)) {
        pg8::Gemm g{YMIX, WOUT_T, M, D, D}; pg8::StaticOrder S; S.init(M, D, G, (int)blockIdx.x);
        pg8::EpiF32 E{Y, D, nullptr};
        pg8::gemm_phase<pg8::EpiF32, pg8::StaticOrder, PG8_ALIGN, PG8_SP2>(lds + RING_OFF, g, S, E);
        if (BOTH(5)) xcd_barrier(bar);
    }
    if (IN(6)) {
        const int gw = vcu * NWAVES + wave, NGW = G * NWAVES;
        for (int m = gw; m < M; m += NGW) post_row(x + (size_t)m * D, Y + (size_t)m * D, args.in[17], args.out + (size_t)m * D, lane);
    }
#undef IN
#undef BOTH
}
extern "C" void kernel_launch(void* const* d_in, const int* in_sizes, int n_in, void* d_out, int out_size, void* d_ws, size_t ws_size, hipStream_t stream) {
    static int grid = 0;
    if (grid == 0) {
        int dev = 0, cus = 0;
        if (hipGetDevice(&dev) != hipSuccess || hipDeviceGetAttribute(&cus, hipDeviceAttributeMultiprocessorCount, dev) != hipSuccess) { fprintf(stderr, "kernel_launch: device query failed\n"); grid = -1; return; }
        if (hipFuncSetAttribute((const void*)mega, hipFuncAttributeMaxDynamicSharedMemorySize, LDS_BYTES) != hipSuccess) { fprintf(stderr, "kernel_launch: hipFuncSetAttribute failed\n"); grid = -1; return; }
        (void)hipGetLastError();
        grid = cus;
    }
    if (grid < 0) return;
    (void)hipMemsetAsync((char*)d_ws + WS_CTL, 0, CTL_ZERO_BYTES, stream);
    Args a{};
    for (int i = 0; i < 18; ++i) a.in[i] = (const float*)d_in[i];
    a.out = (float*)d_out; a.ws = (unsigned char*)d_ws; a.ph_lo = 0; a.ph_hi = 7;
    hipLaunchKernelGGL(mega, dim3(grid), dim3(NWAVES * 64), LDS_BYTES, stream, a);
}
```

```cpp
#include <hip/hip_runtime.h>
#include <cstdio>
#include <cstdint>
namespace pg8 {
#define PG8_LAS __attribute__((address_space(3)))
typedef unsigned short bf16_t;
typedef short bf16x8 __attribute__((ext_vector_type(8)));
typedef float f32x4 __attribute__((ext_vector_type(4)));
typedef unsigned u32x4 __attribute__((ext_vector_type(4)));
constexpr int BM = 256, BK = 64, HALF = 128, HTB = HALF * BK * 2  , STAGE_BYTES = 8 * HTB, NXCD = 8, WGM = 8;

__host__ __device__ __forceinline__ int lds_byte(int r, int c) { const int st = (r >> 4) * 2 + (c >> 5), rr = r & 15, cc = c & 31, ob = rr * 64 + cc * 2; return st * 1024 + (ob ^ (((ob >> 9) & 1) << 5)); }
__host__ __device__ __forceinline__ void stage_rc(int b, int& R, int& C) { const int st = b / 1024, sb = b % 1024, swz = sb ^ (((sb >> 9) & 1) << 5); R = (st >> 1) * 16 + swz / 64; C = (st & 1) * 32 + (swz % 64) / 2; }
__host__ __device__ __forceinline__ int perm32(int rho) { const int n = rho >> 4, i = rho & 15; return 8 * (i >> 2) + 4 * n + (i & 3); }

struct Unit { int pm, pn; };
struct Gemm { const bf16_t* A; const bf16_t* Bt; int M, N, K; };

struct StaticOrder {
    int nM, nN, nwg, G, c;
    __host__ __device__ void init(int M, int N, int G_, int c_) { nM = M / BM; nN = N / BM; nwg = nM * nN; G = G_; c = c_; }
    __host__ __device__ bool next(int i, Unit& u) const {
        const long L = (long)i * G + c; if (L >= nwg) return false;
        int wgid = (int)L; { const int q = nwg / NXCD, r = nwg % NXCD, xcd = wgid % NXCD, off = wgid / NXCD; wgid = (xcd < r ? xcd * (q + 1) : r * (q + 1) + (xcd - r) * q) + off; }
        const int nig = WGM * nN, gid = wgid / nig, fm = gid * WGM, gsz = (nM - fm) < WGM ? (nM - fm) : WGM;
        u.pm = fm + ((wgid % nig) % gsz); u.pn = (wgid % nig) / gsz; return true;
    }
    __device__ __forceinline__ void a_ready(const Unit&) const {}
    __device__ __forceinline__ void done(const Unit&) const {}
};

__device__ __forceinline__ unsigned cvt_pk_bf16(float lo, float hi) { unsigned r; asm volatile("v_cvt_pk_bf16_f32 %0, %1, %2" : "=v"(r) : "v"(lo), "v"(hi)); return r; }
typedef float f32x2 __attribute__((ext_vector_type(2)));
__device__ __forceinline__ f32x2 gelu_pk(f32x2 v) {
    const f32x2 av = __builtin_elementwise_abs(v), d = av * 0.2316418882f + 1.0f;
    f32x2 t; t.x = __builtin_amdgcn_rcpf(d.x); t.y = __builtin_amdgcn_rcpf(d.y);
    f32x2 q = t * 0.5307027145f + (-0.7265760135f); q = q * t + 0.7107068705f; q = q * t + (-0.142248368f); q = q * t + 0.127414796f; q = q * t;
    const f32x2 s = (v * v) * (-0.72134752044f);
    f32x2 e; e.x = __builtin_amdgcn_exp2f(s.x); e.y = __builtin_amdgcn_exp2f(s.y);
    const f32x2 m = v * (q * e), r = v - m;
    f32x2 o; o.x = v.x < 0.f ? m.x : r.x; o.y = v.y < 0.f ? m.y : r.y; return o;
}

template <int ACT  > struct EpiBf16 {
    static constexpr bool PERM = true, AFTER_DRAIN = false; static_assert(ACT == 0 || ACT == 1, "EpiBf16: ACT is 0 (none) or 1 (gelu_pk)");
    bf16_t* O; int ldc; const float* bias; int split_cols; size_t split_stride; float scale0;
    __device__ __forceinline__ void operator()(const f32x4 (&acc)[2][2][4][2], const Unit& u, int wr, int wc, int fr, int fq) const {
        const int row0 = u.pm * BM + wr * 64 + fr; int colt = u.pn * BM; bf16_t* base = O;
        float sc = 1.f; if (split_cols) { const int t = colt / split_cols; base += (size_t)t * split_stride; colt -= t * split_cols; if (t == 0) sc = scale0; }
        const int col0 = colt + wc * 32 + 8 * fq, bcol0 = u.pn * BM + wc * 32 + 8 * fq;
        f32x4 bv[2][2];
#pragma unroll
        for (int bj = 0; bj < 2; ++bj)
#pragma unroll
            for (int n = 0; n < 2; ++n) bv[bj][n] = bias ? *(const f32x4*)(bias + bcol0 + bj * HALF + 4 * n) : (f32x4){0.f, 0.f, 0.f, 0.f};
#pragma unroll
        for (int ai = 0; ai < 2; ++ai)
#pragma unroll
            for (int m = 0; m < 4; ++m) { bf16_t* rowp = base + (size_t)(row0 + ai * HALF + m * 16) * ldc + col0;
#pragma unroll
                for (int bj = 0; bj < 2; ++bj) { f32x4 v0 = acc[ai][bj][m][0] + bv[bj][0], v1 = acc[ai][bj][m][1] + bv[bj][1];
                    if (ACT == 1) { f32x2 a = gelu_pk((f32x2){v0[0], v0[1]}), b = gelu_pk((f32x2){v0[2], v0[3]}), c = gelu_pk((f32x2){v1[0], v1[1]}), d = gelu_pk((f32x2){v1[2], v1[3]});
                        v0 = (f32x4){a.x, a.y, b.x, b.y}; v1 = (f32x4){c.x, c.y, d.x, d.y}; }
                    v0 = v0 * sc; v1 = v1 * sc; u32x4 w; w.x = cvt_pk_bf16(v0[0], v0[1]); w.y = cvt_pk_bf16(v0[2], v0[3]); w.z = cvt_pk_bf16(v1[0], v1[1]); w.w = cvt_pk_bf16(v1[2], v1[3]);
                    *(u32x4*)(rowp + bj * HALF) = w; } }
    }
};
struct EpiF32 {
    static constexpr bool PERM = false, AFTER_DRAIN = false;
    float* C; int ldc; const float* bias;
    __device__ __forceinline__ void operator()(const f32x4 (&acc)[2][2][4][2], const Unit& u, int wr, int wc, int fr, int fq) const {
        const int row0 = u.pm * BM + wr * 64 + fr, col0 = u.pn * BM + wc * 32 + 4 * fq;
        f32x4 bv[2][2];
#pragma unroll
        for (int bj = 0; bj < 2; ++bj)
#pragma unroll
            for (int n = 0; n < 2; ++n) bv[bj][n] = bias ? *(const f32x4*)(bias + col0 + bj * HALF + n * 16) : (f32x4){0.f, 0.f, 0.f, 0.f};
#pragma unroll
        for (int ai = 0; ai < 2; ++ai)
#pragma unroll
            for (int m = 0; m < 4; ++m) { float* rowp = C + (size_t)(row0 + ai * HALF + m * 16) * ldc + col0;
#pragma unroll
                for (int bj = 0; bj < 2; ++bj)
#pragma unroll
                    for (int n = 0; n < 2; ++n) *(f32x4*)(rowp + bj * HALF + n * 16) = acc[ai][bj][m][n] + bv[bj][n]; }
    }
};
struct EpiP {
    static constexpr bool PERM = true, AFTER_DRAIN = false;
    bf16_t* O; int ldc; const float* lbl;
    __device__ __forceinline__ void operator()(const f32x4 (&acc)[2][2][4][2], const Unit& u, int wr, int wc, int fr, int fq) const {
        const int row0 = u.pm * BM + wr * 64 + fr, col0 = u.pn * BM + wc * 32 + 8 * fq;
        const int mode = (u.pn >= 11 && u.pn <= 14) ? 1 : (u.pn >= 17 ? 2 : 0);
        f32x4 om[2][2];
#pragma unroll
        for (int bj = 0; bj < 2; ++bj)
#pragma unroll
            for (int n = 0; n < 2; ++n) {
                om[bj][n] = (f32x4){1.f, 1.f, 1.f, 1.f};
                if (mode == 1) { const int ch = (col0 + bj * HALF + 4 * n - 2816) & 511;
                    const f32x4 l0 = *(const f32x4*)(lbl + ch), l1 = *(const f32x4*)(lbl + 512 + ch);
#pragma unroll
                    for (int e = 0; e < 4; ++e) om[bj][n][e] = 1.0f - 1.0f / (1.0f + __expf(-(l0[e] - l1[e]))); }
            }
#pragma unroll
        for (int ai = 0; ai < 2; ++ai)
#pragma unroll
            for (int m = 0; m < 4; ++m) { bf16_t* rowp = O + (size_t)(row0 + ai * HALF + m * 16) * ldc + col0;
#pragma unroll
                for (int bj = 0; bj < 2; ++bj) { f32x4 v0 = acc[ai][bj][m][0], v1 = acc[ai][bj][m][1];
                    if (mode == 1) {
#pragma unroll
                        for (int e = 0; e < 4; ++e) { v0[e] = om[bj][0][e] / (1.0f + __expf(v0[e])); v1[e] = om[bj][1][e] / (1.0f + __expf(v1[e])); } }
                    else if (mode == 2) {
#pragma unroll
                        for (int e = 0; e < 4; ++e) { v0[e] = v0[e] / (1.0f + __expf(-v0[e])); v1[e] = v1[e] / (1.0f + __expf(-v1[e])); } }
                    u32x4 w; w.x = cvt_pk_bf16(v0[0], v0[1]); w.y = cvt_pk_bf16(v0[2], v0[3]); w.z = cvt_pk_bf16(v1[0], v1[1]); w.w = cvt_pk_bf16(v1[2], v1[3]);
                    *(u32x4*)(rowp + bj * HALF) = w; } }
    }
};
template <class Epi, class Sched, bool ALIGN_EPI = false, bool SP2 = false>
__device__ __forceinline__ void gemm_phase(PG8_LAS unsigned char* lds, const Gemm g, const Sched& S, const Epi& E) {
    const int tid = threadIdx.x, wid = __builtin_amdgcn_readfirstlane(tid >> 6), lane = tid & 63, wr = wid >> 2, wc = wid & 3, fr = lane & 15, fq = lane >> 4;
    const int K = g.K, nt = K / BK;
    unsigned voffA[2], voffB[2];
#pragma unroll
    for (int i = 0; i < 2; ++i) { int R, C; stage_rc(tid * 16 + i * 8192, R, C); const int Rb = Epi::PERM ? ((R & ~31) + perm32(R & 31)) : R;
        voffA[i] = (unsigned)(R * K + C) * 2u; voffB[i] = (unsigned)(Rb * K + C) * 2u; }
    const size_t kstep = (size_t)(BK * 2);
    const size_t hstep = (size_t)HALF * K * 2;
    const size_t tstep = 2 * hstep;
    const unsigned ldsw = (unsigned)wid * 1024u;
    const int aoff = lds_byte(wr * 64 + fr, fq * 8), boff = lds_byte(wc * 32 + fr, fq * 8);
#define PG8_SA(b, h) (((b) * 2 + (h)) * HTB)
#define PG8_SB(b, h) ((4 + (b) * 2 + (h)) * HTB)
#define PG8_STAGE(bufoff, gbase, voff) do { _Pragma("unroll") for (int _i = 0; _i < 2; ++_i) \
        __builtin_amdgcn_global_load_lds((const unsigned*)((const char*)(gbase) + (voff)[_i]), (PG8_LAS unsigned*)(lds + (bufoff) + ldsw + _i * 8192), 16, 0, 0); } while (0)
#define PG8_LDA(dst, b, h) do { _Pragma("unroll") for (int m = 0; m < 4; ++m) _Pragma("unroll") for (int k = 0; k < 2; ++k) dst[m][k] = *(const PG8_LAS bf16x8*)(lds + PG8_SA(b, h) + aoff + m * 2048 + k * 1024); } while (0)
#define PG8_LDB(dst, b, h) do { _Pragma("unroll") for (int n = 0; n < 2; ++n) _Pragma("unroll") for (int k = 0; k < 2; ++k) dst[n][k] = *(const PG8_LAS bf16x8*)(lds + PG8_SB(b, h) + boff + n * 2048 + k * 1024); } while (0)
#define PG8_MMA(ai, bj, At, Bt) do { __builtin_amdgcn_s_setprio(1); _Pragma("unroll") for (int m = 0; m < 4; ++m) _Pragma("unroll") for (int n = 0; n < 2; ++n) _Pragma("unroll") for (int k = 0; k < 2; ++k) \
        acc[ai][bj][m][n] = __builtin_amdgcn_mfma_f32_16x16x32_bf16(Bt[n][k], At[m][k], acc[ai][bj][m][n], 0, 0, 0); __builtin_amdgcn_s_setprio(0); } while (0)
#define PG8_WAIT_V(n) asm volatile("s_waitcnt vmcnt(" #n ")" ::: "memory")
#define PG8_WAIT_L(n) asm volatile("s_waitcnt lgkmcnt(" #n ")" ::: "memory")
#define PG8_BAR __builtin_amdgcn_s_barrier()
#define PG8_SCHED __builtin_amdgcn_sched_barrier(0)
    Unit cur, nxt; int ui = 0;
    if (!S.next(0, cur)) return;
    f32x4 acc[2][2][4][2];
#pragma unroll
    for (int a = 0; a < 2; ++a)
#pragma unroll
        for (int b = 0; b < 2; ++b)
#pragma unroll
            for (int m = 0; m < 4; ++m)
#pragma unroll
                for (int n = 0; n < 2; ++n) acc[a][b][m][n] = (f32x4){0.f, 0.f, 0.f, 0.f};
    bf16x8 At[4][2], B0[2][2], B1[2][2];
    const char* cA = (const char*)g.A + (size_t)cur.pm * tstep; const char* cB = (const char*)g.Bt + (size_t)cur.pn * tstep;
    S.a_ready(cur);
    if constexpr (SP2) {
        PG8_STAGE(PG8_SB(0, 0), cB, voffB); PG8_STAGE(PG8_SB(0, 1), cB + hstep, voffB); PG8_STAGE(PG8_SA(0, 0), cA, voffA); PG8_STAGE(PG8_SA(0, 1), cA + hstep, voffA);
        if (wr == 1) PG8_BAR;
        PG8_WAIT_V(2); PG8_BAR;
        PG8_STAGE(PG8_SB(1, 0), cB + kstep, voffB); PG8_STAGE(PG8_SA(1, 0), cA + kstep, voffA); PG8_STAGE(PG8_SB(1, 1), cB + hstep + kstep, voffB);
        PG8_WAIT_V(6); PG8_BAR;
    } else {
        PG8_STAGE(PG8_SB(0, 0), cB, voffB); PG8_STAGE(PG8_SA(0, 0), cA, voffA); PG8_STAGE(PG8_SB(0, 1), cB + hstep, voffB); PG8_STAGE(PG8_SA(0, 1), cA + hstep, voffA);
        if (wr == 1) PG8_BAR;
        PG8_WAIT_V(4); PG8_BAR;
        PG8_STAGE(PG8_SB(1, 0), cB + kstep, voffB); PG8_STAGE(PG8_SA(1, 0), cA + kstep, voffA); PG8_STAGE(PG8_SB(1, 1), cB + hstep + kstep, voffB);
        PG8_WAIT_V(6); PG8_BAR;
    }
    for (;;) {
        const bool has_next = S.next(ui + 1, nxt);
        const char* nA = has_next ? (const char*)g.A + (size_t)nxt.pm * tstep : cA; const char* nB = has_next ? (const char*)g.Bt + (size_t)nxt.pn * tstep : cB;
        for (int t = 0; t < nt; t += 2) {
            const bool last = (t == nt - 2);
            const char* a1 = cA + (size_t)(t + 1) * kstep;
            const char* a2 = last ? nA : cA + (size_t)(t + 2) * kstep; const char* b2 = last ? nB : cB + (size_t)(t + 2) * kstep;
            const char* a3 = a2 + kstep; const char* b3 = b2 + kstep;
            if (last && has_next) S.a_ready(nxt);
            if constexpr (SP2) {
            PG8_LDB(B0, 0, 0); PG8_LDB(B1, 0, 1); PG8_SCHED; PG8_LDA(At, 0, 0); PG8_STAGE(PG8_SA(1, 1), a1 + hstep, voffA);
            PG8_WAIT_V(8); PG8_WAIT_L(0); PG8_BAR; PG8_MMA(0, 0, At, B0); PG8_MMA(0, 1, At, B1); PG8_BAR; PG8_SCHED;
            PG8_LDA(At, 0, 1); PG8_STAGE(PG8_SB(0, 0), b2, voffB); PG8_STAGE(PG8_SB(0, 1), b2 + hstep, voffB); PG8_STAGE(PG8_SA(0, 0), a2, voffA);
            PG8_WAIT_V(8); PG8_WAIT_L(0); PG8_BAR; PG8_MMA(1, 0, At, B0); PG8_MMA(1, 1, At, B1); PG8_BAR; PG8_SCHED;
            PG8_LDB(B0, 1, 0); PG8_LDB(B1, 1, 1); PG8_SCHED; PG8_LDA(At, 1, 0); PG8_STAGE(PG8_SA(0, 1), a2 + hstep, voffA);
            PG8_WAIT_V(8); PG8_WAIT_L(0); PG8_BAR; PG8_MMA(0, 0, At, B0); PG8_MMA(0, 1, At, B1); PG8_BAR; PG8_SCHED;
            PG8_LDA(At, 1, 1); PG8_STAGE(PG8_SB(1, 0), b3, voffB); PG8_STAGE(PG8_SB(1, 1), b3 + hstep, voffB); PG8_STAGE(PG8_SA(1, 0), a3, voffA);
            PG8_WAIT_V(8); PG8_WAIT_L(0); PG8_BAR; PG8_MMA(1, 0, At, B0); PG8_MMA(1, 1, At, B1); PG8_BAR; PG8_SCHED;
            } else {
            PG8_LDB(B0, 0, 0); PG8_SCHED; PG8_LDA(At, 0, 0); PG8_STAGE(PG8_SA(1, 1), a1 + hstep, voffA);
            PG8_WAIT_L(8); PG8_BAR; PG8_WAIT_L(0); PG8_MMA(0, 0, At, B0); PG8_BAR; PG8_SCHED;
            PG8_LDB(B1, 0, 1); PG8_STAGE(PG8_SB(0, 0), b2, voffB);
            PG8_BAR; PG8_WAIT_L(0); PG8_MMA(0, 1, At, B1); PG8_BAR;
            PG8_LDA(At, 0, 1); PG8_STAGE(PG8_SA(0, 0), a2, voffA);
            PG8_BAR; PG8_WAIT_L(0); PG8_MMA(1, 0, At, B0); PG8_BAR; PG8_SCHED;
            PG8_STAGE(PG8_SB(0, 1), b2 + hstep, voffB);
            PG8_WAIT_V(6); PG8_BAR; PG8_MMA(1, 1, At, B1); PG8_BAR;
            PG8_LDB(B0, 1, 0); PG8_SCHED; PG8_LDA(At, 1, 0); PG8_STAGE(PG8_SA(0, 1), a2 + hstep, voffA);
            PG8_WAIT_L(8); PG8_BAR; PG8_WAIT_L(0); PG8_MMA(0, 0, At, B0); PG8_BAR; PG8_SCHED;
            PG8_LDB(B1, 1, 1); PG8_STAGE(PG8_SB(1, 0), b3, voffB);
            PG8_BAR; PG8_WAIT_L(0); PG8_MMA(0, 1, At, B1); PG8_BAR;
            PG8_LDA(At, 1, 1); PG8_STAGE(PG8_SA(1, 0), a3, voffA);
            PG8_BAR; PG8_WAIT_L(0); PG8_MMA(1, 0, At, B0); PG8_BAR; PG8_SCHED;
            PG8_STAGE(PG8_SB(1, 1), b3 + hstep, voffB);
            PG8_WAIT_V(6); PG8_BAR; PG8_MMA(1, 1, At, B1); PG8_BAR;
            }
        }
        if constexpr (ALIGN_EPI) { if (wr == 0) PG8_BAR; }
        if constexpr (!Epi::AFTER_DRAIN) { E(acc, cur, wr, wc, fr, fq); S.done(cur); }
        if (!has_next) break;
#pragma unroll
        for (int a = 0; a < 2; ++a)
#pragma unroll
            for (int b = 0; b < 2; ++b)
#pragma unroll
                for (int m = 0; m < 4; ++m)
#pragma unroll
                    for (int n = 0; n < 2; ++n) acc[a][b][m][n] = (f32x4){0.f, 0.f, 0.f, 0.f};
        cur = nxt; cA = nA; cB = nB; ++ui;
        if constexpr (ALIGN_EPI) { if (wr == 1) PG8_BAR; }
    }
    PG8_WAIT_V(0);
    if constexpr (!ALIGN_EPI) { if (wr == 0) PG8_BAR; }
    PG8_BAR;
    if constexpr (Epi::AFTER_DRAIN) { E.fused(acc, cur, wr, wc, fr, fq, lds, wid, lane); S.done(cur); }
#undef PG8_SA
#undef PG8_SB
#undef PG8_STAGE
#undef PG8_LDA
#undef PG8_LDB
#undef PG8_MMA
#undef PG8_WAIT_V
#undef PG8_WAIT_L
#undef PG8_BAR
#undef PG8_SCHED
}
}

#ifndef PG8_SP2
#define PG8_SP2 true
#endif
#ifndef PG8_ALIGN
#define PG8_ALIGN true
#endif
#define GAS __attribute__((address_space(1)))
#define LAS __attribute__((address_space(3)))
typedef unsigned short bf16;
typedef unsigned v4u __attribute__((ext_vector_type(4)));
typedef float f32x4 __attribute__((ext_vector_type(4)));
typedef short bf16x8 __attribute__((ext_vector_type(8)));
typedef GAS unsigned gu32;
typedef GAS unsigned long long gu64;
#define RLX_AGENT __ATOMIC_RELAXED, __HIP_MEMORY_SCOPE_AGENT
#define LDS_WAIT() asm volatile("s_waitcnt lgkmcnt(0)" ::: "memory")
#define VM_WAIT() asm volatile("s_waitcnt vmcnt(0)" ::: "memory")
__device__ __forceinline__ unsigned long long rt() { return __builtin_amdgcn_s_memrealtime(); }
__device__ __forceinline__ unsigned f2bf(float f) { unsigned u = __builtin_bit_cast(unsigned, f); return (u + 0x7fffu + ((u >> 16) & 1u)) >> 16; }
__device__ __forceinline__ unsigned pk2(float lo, float hi) { return f2bf(lo) | (f2bf(hi) << 16); }

#define XB_TMO      128
#define XB_XCNT(j)  (256  + 64 * (j))
#define XB_XSUB(j)  (1280 + 64 * (j))
#define XB_XGEN(j)  (2304 + 64 * (j))
#define XB_TOP      3328
#define XB_TOPGEN   3392
#define XCD_BAR_WORDS 3456
#define XB_SPIN_CAP (1u << 22)

__device__ __forceinline__ unsigned xb_ld(unsigned* p)              { return __hip_atomic_load(p, __ATOMIC_RELAXED, __HIP_MEMORY_SCOPE_AGENT); }
__device__ __forceinline__ unsigned xb_add(unsigned* p, unsigned v) { return __hip_atomic_fetch_add(p, v, __ATOMIC_RELAXED, __HIP_MEMORY_SCOPE_AGENT); }
__device__ __forceinline__ unsigned xb_xcc_id() { return (unsigned)__builtin_amdgcn_s_getreg((3 << 11) | 20) & 0xFu; }
#define XB_SPIN(cond, bar) do { unsigned _sp = 0; while (cond) { __builtin_amdgcn_s_sleep(1); \
    if ((++_sp & 255u) == 0u) { if (xb_ld(&(bar)[XB_TMO])) break; if (_sp > XB_SPIN_CAP) { atomicAdd(&(bar)[XB_TMO], 1u); break; } } } } while (0)

struct XcdBarrier {
    unsigned* bar; unsigned x;
    volatile LAS unsigned* st;
};

__device__ __forceinline__ XcdBarrier xcd_barrier_post(unsigned* bar, volatile LAS unsigned* st) {
    XcdBarrier b; b.bar = bar; b.x = xb_xcc_id(); b.st = st;
    if (threadIdx.x == 0) (void)xb_add(&bar[XB_XCNT(b.x)], 1u);
    return b;
}
__device__ __forceinline__ void xcd_barrier_complete(unsigned* bar, unsigned x, unsigned& nloc, unsigned& nx) {
    const unsigned G = gridDim.x * gridDim.y * gridDim.z;
    unsigned sum, cnt, mine, sp = 0u;
    for (;;) {
        sum = 0u; cnt = 0u; mine = 0u;
#pragma unroll
        for (unsigned j = 0; j < 16; ++j) { const unsigned c = xb_ld(&bar[XB_XCNT(j)]); sum += c; cnt += (c > 0u) ? 1u : 0u; mine = (j == x) ? c : mine; }
        if (sum == G) break;
        __builtin_amdgcn_s_sleep(1);
        if ((++sp & 255u) == 0u) { if (xb_ld(&bar[XB_TMO])) break; if (sp > XB_SPIN_CAP) { atomicAdd(&bar[XB_TMO], 1u); break; } }
    }
    nloc = mine > 0u ? mine : 1u; nx = cnt > 0u ? cnt : 1u;
}

__device__ __forceinline__ void xcd_barrier(const XcdBarrier& b) {
    asm volatile("s_waitcnt vmcnt(0)" ::: "memory");
    __syncthreads();
    if (threadIdx.x == 0) {
        unsigned* bar = b.bar;
        __builtin_amdgcn_s_waitcnt(0);
        unsigned nloc = b.st[0], nx = b.st[1];
        if (nloc == 0u) { xcd_barrier_complete(bar, b.x, nloc, nx); b.st[0] = nloc; b.st[1] = nx; }
        const unsigned old = xb_add(&bar[XB_XSUB(b.x)], 1u);
        const unsigned gen = old / nloc;
        if (old + 1u == (gen + 1u) * nloc) {
            __builtin_amdgcn_fence(__ATOMIC_RELEASE, "agent");
            asm volatile("s_waitcnt vmcnt(0)" ::: "memory");
            const unsigned og = xb_add(&bar[XB_TOP], 1u);
            const unsigned tg = og / nx;
            if (og + 1u == (tg + 1u) * nx) xb_add(&bar[XB_TOPGEN], 1u);
            else XB_SPIN(xb_ld(&bar[XB_TOPGEN]) == tg, bar);
            __builtin_amdgcn_fence(__ATOMIC_ACQUIRE, "agent");
            xb_add(&bar[XB_XGEN(b.x)], 1u);
            asm volatile("s_waitcnt vmcnt(0)" ::: "memory");
        } else {
            XB_SPIN(xb_ld(&bar[XB_XGEN(b.x)]) == gen, bar);
            __builtin_amdgcn_fence(__ATOMIC_ACQUIRE, "agent");
            asm volatile("s_waitcnt vmcnt(0)" ::: "memory");
        }
    }
    __syncthreads();
}
constexpr int NWAVES = 8;
constexpr int BATCH = 4, T = 4096, D = 1024, M = BATCH * T;
constexpr int RW_W = 512, RW_COLS = 2304, HG_COLS = 2560, IN_COLS = 4864;
constexpr size_t MiB = 1u << 20;
constexpr size_t WS_CTL = 0, CTL_ZERO_BYTES = 1 * MiB;
constexpr size_t WS_P = 1 * MiB;
constexpr size_t WS_XN = 153 * MiB;
constexpr size_t WS_WIN = 185 * MiB;
constexpr size_t WS_WOUT = 249 * MiB;
constexpr size_t WS_BON = 251 * MiB;
constexpr size_t WS_W2T = 252 * MiB;
constexpr size_t WS_A2T = 252 * MiB + 131072;
constexpr size_t WS_OHG = 153 * MiB;
constexpr size_t WS_Q = 185 * MiB;
constexpr size_t WS_Y = 217 * MiB;
constexpr size_t WS_END = 256 * MiB;
constexpr int CW_TMO = 0, CW_CODE = 1, CW_BAR = 4096;
constexpr int RING_OFF = 0, RING_BYTES = 143360;
constexpr int LDSCTL_OFF = RING_BYTES, MISC_OFF = LDSCTL_OFF + 320;
constexpr int LDS_BYTES = 147456;
__device__ __forceinline__ float wave_sum(float v) {
#pragma unroll
    for (int o = 1; o < 64; o <<= 1) v += __shfl_xor(v, o);
    return v;
}
__device__ __forceinline__ void p0_transpose_item(const float* W, int K, int N, bf16* WT, LAS float* scr, int item, int lane) {
    const int nblk = N / 32, kb = item / nblk, nb = item % nblk, k0 = 64 * kb, n0 = 32 * nb;
#pragma unroll 8
    for (int i = 0; i < 32; ++i) { const int kk = 2 * i + (lane >> 5); scr[kk * 33 + (lane & 31)] = W[(size_t)(k0 + kk) * N + n0 + (lane & 31)]; }
    LDS_WAIT(); asm volatile("" ::: "memory");
    const int c = lane & 7;
#pragma unroll
    for (int j = 0; j < 4; ++j) { const int n = (lane >> 3) + 8 * j; const LAS float* s = scr + (8 * c) * 33 + n;
        v4u o; o.x = pk2(s[0 * 33], s[1 * 33]); o.y = pk2(s[2 * 33], s[3 * 33]); o.z = pk2(s[4 * 33], s[5 * 33]); o.w = pk2(s[6 * 33], s[7 * 33]);
        *(GAS v4u*)(WT + (size_t)(n0 + n) * K + k0 + 8 * c) = o; }
    LDS_WAIT(); asm volatile("" ::: "memory");
}
__device__ __forceinline__ void rms_row_to_bf16(const float* xrow, const float* g, bf16* orow, int lane) {
    const GAS f32x4* xr = (const GAS f32x4*)xrow + lane;
    const GAS f32x4* gr = (const GAS f32x4*)g + lane;
    f32x4 v[4]; float s = 0.f;
#pragma unroll
    for (int j = 0; j < 4; ++j) { v[j] = xr[64 * j]; s += (v[j].x * v[j].x + v[j].y * v[j].y) + (v[j].z * v[j].z + v[j].w * v[j].w); }
    const float rstd = 1.f / sqrtf(wave_sum(s) * (1.f / D) + 1e-6f);
    GAS unsigned long long* o8 = (GAS unsigned long long*)orow + lane;
#pragma unroll
    for (int j = 0; j < 4; ++j) { const f32x4 gv = gr[64 * j];
        o8[64 * j] = (unsigned long long)pk2(v[j].x * rstd * gv.x, v[j].y * rstd * gv.y) | ((unsigned long long)pk2(v[j].z * rstd * gv.z, v[j].w * rstd * gv.w) << 32); }
}

__device__ __forceinline__ float bfu(bf16 b) { return __uint_as_float(((unsigned)b) << 16); }
__device__ __forceinline__ float shifted_tok(const bf16* __restrict__ p, int b, int t, int c, float mup, float mun) {
    const size_t row = (size_t)b * T + t;
    const float cur = bfu(p[row * IN_COLS + c]);
    const float prv = t > 0 ? bfu(p[(row - 1) * IN_COLS + c]) : 0.f;
    const float nxt = t < T - 1 ? bfu(p[(row + 1) * IN_COLS + c]) : 0.f;
    return cur + mup * (prv - cur) + mun * (nxt - cur);
}
__device__ __forceinline__ float sigmoidf_(float v) { return 1.0f / (1.0f + __expf(-v)); }

__device__ __forceinline__ void mix_row(const bf16* __restrict__ p, const float* const* in, const bf16* __restrict__ Yarr, const float* __restrict__ bonus, const bf16* __restrict__ o_hg, bf16* __restrict__ ymix, int row, int lane) {
    const float* mu_prev = in[3]; const float* mu_next = in[4]; const float* ln_w = in[12]; const float* ln_b = in[13]; const float* norm_g = in[15];
    const int b = row / T, t = row % T;
#pragma unroll 2
    for (int i = 0; i < 8; ++i) {
        const int c = i * 64 + lane;
        const size_t itf = ((size_t)((0 * 4 + b) * 8 + i)) * 64 + (t >> 6), itb = ((size_t)((1 * 4 + b) * 8 + i)) * 64 + (63 - (t >> 6));
        const float y = bfu(Yarr[itf * 4096 + (t & 63) * 64 + lane]) + bfu(Yarr[itb * 4096 + (63 - (t & 63)) * 64 + lane]);
        const float mu = wave_sum(y) * (1.0f / 64.0f);
        const float dlt = y - mu;
        const float var = wave_sum(dlt * dlt) * (1.0f / 64.0f);
        float yn = dlt * (1.0f / sqrtf(var + 64e-5f)) * ln_w[c] + ln_b[c];
        const float vs = shifted_tok(p, b, t, 1024 + c, mu_prev[1024 + c], mu_next[1024 + c]);
        const float gs = shifted_tok(p, b, t, 1536 + c, mu_prev[1536 + c], mu_next[1536 + c]);
        const float bo = bonus[(size_t)row * 8 + i] + bonus[((size_t)M + row) * 8 + i];
        yn += bo * vs;
        ymix[(size_t)row * 1024 + c] = (bf16)f2bf(yn * gs * sigmoidf_(gs));
    }
#pragma unroll
    for (int hh = 0; hh < 4; ++hh) {
        const int c0 = hh * 128 + lane, c1 = c0 + 64;
        const float o0 = bfu(o_hg[(size_t)row * 512 + c0]) + bfu(o_hg[((size_t)M + row) * 512 + c0]);
        const float o1 = bfu(o_hg[(size_t)row * 512 + c1]) + bfu(o_hg[((size_t)M + row) * 512 + c1]);
        const float rstd = 1.0f / sqrtf(wave_sum(o0 * o0 + o1 * o1) * (1.0f / 128.0f) + 1e-6f);
        const float g0 = bfu(p[(size_t)row * IN_COLS + RW_COLS + 2048 + c0]), g1 = bfu(p[(size_t)row * IN_COLS + RW_COLS + 2048 + c1]);
        ymix[(size_t)row * 1024 + 512 + c0] = (bf16)f2bf(o0 * rstd * norm_g[lane] * g0);
        ymix[(size_t)row * 1024 + 512 + c1] = (bf16)f2bf(o1 * rstd * norm_g[64 + lane] * g1);
    }
}
__device__ __forceinline__ void post_row(const float* xrow, const float* yrow, const float* g, float* orow, int lane) {
    const GAS f32x4* yr = (const GAS f32x4*)yrow + lane; const GAS f32x4* xr = (const GAS f32x4*)xrow + lane; const GAS f32x4* gr = (const GAS f32x4*)g + lane;
    f32x4 v[4]; float s = 0.f;
#pragma unroll
    for (int j = 0; j < 4; ++j) { v[j] = yr[64 * j]; s += (v[j].x * v[j].x + v[j].y * v[j].y) + (v[j].z * v[j].z + v[j].w * v[j].w); }
    const float rstd = 1.f / sqrtf(wave_sum(s) * (1.f / D) + 1e-6f);
    GAS f32x4* o4 = (GAS f32x4*)orow + lane;
#pragma unroll
    for (int j = 0; j < 4; ++j) o4[64 * j] = xr[64 * j] + v[j] * rstd * gr[64 * j];
}
typedef unsigned v2u __attribute__((ext_vector_type(2)));
__device__ __forceinline__ f32x4 mfma16(bf16x8 a, bf16x8 b, f32x4 c) { return __builtin_amdgcn_mfma_f32_16x16x32_bf16(a, b, c, 0, 0, 0); }
constexpr int MS = 144;
constexpr int MB = 64 * MS;
constexpr int A_LWO = 0, A_LAO = 16384;
constexpr int A_LQ = 0, A_PKK = 16384;
constexpr int A_TW = 32768, A_AD = 32768 + MB;
constexpr int A_WP = 32768;
constexpr int A_KKT = 51200, A_RT = A_KKT + MB, A_KH = A_RT + MB, A_BH = A_KH + MB, A_KHT = A_BH + MB, A_BHT = A_KHT + MB, A_VT = A_BHT + MB;
constexpr int A_XT = A_KH;
constexpr int A_PRB = A_VT + MB, A_PRK = A_PRB + MB;
constexpr int A_EC = A_PRK + MB, A_SEG = A_EC + 256, A_END = A_SEG + 2048;
static_assert(A_VT + MB == 115712 && A_END <= 143360, "2a LDS map");
constexpr int WPS = 72;

__device__ __forceinline__ bf16x8 ldsfrag(LAS const unsigned char* base, int row0, int k0, int lane) {
    return *(const LAS bf16x8*)(base + (row0 + (lane & 15)) * MS + (k0 + 8 * (lane >> 4)) * 2);
}
template <int CTRL> __device__ __forceinline__ float dppx(float x) { return __int_as_float(__builtin_amdgcn_update_dpp(0, __float_as_int(x), CTRL, 0xF, 0xF, true)); }
__device__ __forceinline__ float wsum(float x) {
    x += dppx<0xB1>(x); x += dppx<0x4E>(x); x += dppx<0x141>(x); x += dppx<0x140>(x);
    const int xi = __float_as_int(x);
    const float a = __int_as_float(__builtin_amdgcn_readlane(xi, 0)), b = __int_as_float(__builtin_amdgcn_readlane(xi, 16)), c = __int_as_float(__builtin_amdgcn_readlane(xi, 32)), d = __int_as_float(__builtin_amdgcn_readlane(xi, 48));
    return (a + b) + (c + d);
}
__device__ __forceinline__ float quad_sum(float x) { x += dppx<0xB1>(x); x += dppx<0x4E>(x); return x; }
typedef __bf16 bf16x2_t __attribute__((ext_vector_type(2)));
typedef float f32x2_t __attribute__((ext_vector_type(2)));
__device__ __forceinline__ unsigned pkbf(float lo, float hi) { f32x2_t v = {lo, hi}; bf16x2_t b = __builtin_convertvector(v, bf16x2_t); return __builtin_bit_cast(unsigned, b); }
__device__ __forceinline__ bf16 bf1(float v) { return (bf16)(pkbf(v, 0.f) & 0xffffu); }

__device__ __forceinline__ void rw2a_item(LAS unsigned char* lds, const bf16* __restrict__ P, const float* const* in, const bf16* __restrict__ W2T, const bf16* __restrict__ A2T,
                                          bf16* __restrict__ Marr, bf16* __restrict__ Narr, bf16* __restrict__ Qarr, bf16* __restrict__ Yarr, float* __restrict__ BON,
                                          int b, int h, int c, int tid, int lane, int wave) {
    const float* mu_prev = in[3]; const float* mu_next = in[4];
    const int g = lane >> 4, l15 = lane & 15;
    const size_t rowbase = (size_t)b * T + (size_t)c * 64;
#pragma unroll 1
    for (int d = 0; d < 2; ++d) {
        const int cs = d ? 63 - c : c;
        const size_t item = ((size_t)((d * 4 + b) * 8 + h)) * 64 + cs;
        {
            const int tau = tid >> 3, cg = tid & 7;
            const int t = c * 64 + tau;
#pragma unroll
            for (int arr = 0; arr < 2; ++arr) {
                const int col0 = (arr == 0 ? 2048 : 2176) + d * 64 + 8 * cg;
                const bf16* pr = P + (rowbase + tau) * IN_COLS + col0;
                const v4u cur = *(const v4u*)pr;
                v4u prv = (v4u){0u, 0u, 0u, 0u}, nxt = (v4u){0u, 0u, 0u, 0u};
                if (t > 0) prv = *(const v4u*)(pr - IN_COLS);
                if (t < T - 1) nxt = *(const v4u*)(pr + IN_COLS);
                const f32x4 mp0 = *(const f32x4*)(mu_prev + col0), mp1 = *(const f32x4*)(mu_prev + col0 + 4);
                const f32x4 mn0 = *(const f32x4*)(mu_next + col0), mn1 = *(const f32x4*)(mu_next + col0 + 4);
                float o[8];
#pragma unroll
                for (int e = 0; e < 8; ++e) {
                    const unsigned cw = cur[e >> 1], pw = prv[e >> 1], nw = nxt[e >> 1];
                    const float cv = __uint_as_float((e & 1) ? (cw & 0xffff0000u) : (cw << 16));
                    const float pv = __uint_as_float((e & 1) ? (pw & 0xffff0000u) : (pw << 16));
                    const float nv = __uint_as_float((e & 1) ? (nw & 0xffff0000u) : (nw << 16));
                    const float mp = e < 4 ? mp0[e & 3] : mp1[e & 3], mn = e < 4 ? mn0[e & 3] : mn1[e & 3];
                    float sv = cv + mp * (pv - cv) + mn * (nv - cv);
                    if (arr == 0) { const float ex = __expf(2.0f * sv); sv = 1.0f - 2.0f / (ex + 1.0f); }
                    o[e] = sv;
                }
                v4u w; w.x = pkbf(o[0], o[1]); w.y = pkbf(o[2], o[3]); w.z = pkbf(o[4], o[5]); w.w = pkbf(o[6], o[7]);
                *(LAS v4u*)(lds + (arr == 0 ? A_TW : A_AD) + tau * MS + cg * 16) = w;
            }
        }
        const int j = tid & 63, seg = tid >> 6;
        const int ch = h * 64 + j;
        unsigned short raw[3][10];
#pragma unroll
        for (int a3 = 0; a3 < 3; ++a3)
#pragma unroll
            for (int rr = 0; rr < 10; ++rr) {
                const int tau = d ? (64 - 8 * seg - rr) : (8 * seg - 1 + rr); const int t = c * 64 + tau;
                raw[a3][rr] = (t >= 0 && t < T) ? P[(size_t)((long)rowbase + tau) * IN_COLS + a3 * 512 + ch] : (unsigned short)0;
            }
        __syncthreads();
        {
            const int p = wave >> 2, tt = wave & 3;
            const bf16* WT = (p == 0 ? W2T : A2T) + ((size_t)d * 512 + h * 64) * 64;
            const bf16x8 a0 = ldsfrag(lds + (p == 0 ? A_TW : A_AD), 16 * tt, 0, lane), a1 = ldsfrag(lds + (p == 0 ? A_TW : A_AD), 16 * tt, 32, lane);
#pragma unroll
            for (int jt = 0; jt < 4; ++jt) {
                const bf16* bp = WT + (size_t)(16 * jt + l15) * 64 + 8 * g;
                const bf16x8 b0 = *(const bf16x8*)bp, b1 = *(const bf16x8*)(bp + 32);
                f32x4 acc = (f32x4){0.f, 0.f, 0.f, 0.f};
                acc = mfma16(a0, b0, acc); acc = mfma16(a1, b1, acc);
                LAS float* o = (LAS float*)(lds + (p == 0 ? A_LWO : A_LAO)) + (16 * tt + 4 * g) * 64 + 16 * jt + l15;
#pragma unroll
                for (int rg = 0; rg < 4; ++rg) o[rg * 64] = acc[rg];
            }
        }
        __syncthreads();
        float lw[8], cl[8];
        {
            const float w0c = in[5][d * 512 + ch];
            float run = 0.f;
#pragma unroll
            for (int i = 0; i < 8; ++i) {
                const int sg = 8 * seg + i, tau = d ? 63 - sg : sg;
                const float wr = w0c + ((const LAS float*)(lds + A_LWO))[tau * 64 + j];
                lw[i] = -0.60653065971f / (1.0f + __expf(-wr));
                run += lw[i]; cl[i] = run;
            }
            ((LAS float*)(lds + A_SEG))[seg * 64 + j] = run;
        }
        __syncthreads();
        float off = 0.f, ctot = 0.f;
#pragma unroll
        for (int s8 = 0; s8 < 8; ++s8) { const float v = ((const LAS float*)(lds + A_SEG))[s8 * 64 + j]; if (s8 < seg) off += v; ctot += v; }
        if (seg == 7) ((LAS float*)(lds + A_EC))[j] = __expf(ctot);
        {
            const float a0c = in[7][d * 512 + ch], kkc = in[9][ch], kac = in[10][ch], rkc = in[11][ch];
            const float mpr = mu_prev[ch], mnr = mu_next[ch], mpk = mu_prev[512 + ch], mnk = mu_next[512 + ch], mpv = mu_prev[1024 + ch], mnv = mu_next[1024 + ch];
            float kht[8], bht[8], vt[8];
#pragma unroll
            for (int i = 0; i < 8; ++i) {
                const int sg = 8 * seg + i, tau = d ? 63 - sg : sg;
                float sh[3];
#pragma unroll
                for (int a3 = 0; a3 < 3; ++a3) {
                    const float cv = __uint_as_float((unsigned)raw[a3][i + 1] << 16), lo_ = __uint_as_float((unsigned)raw[a3][i] << 16), hi_ = __uint_as_float((unsigned)raw[a3][i + 2] << 16);
                    const float pv = d ? hi_ : lo_, nv = d ? lo_ : hi_;
                    const float mp = a3 == 0 ? mpr : (a3 == 1 ? mpk : mpv), mn = a3 == 0 ? mnr : (a3 == 1 ? mnk : mnv);
                    sh[a3] = cv + mp * (pv - cv) + mn * (nv - cv);
                }
                const float rs = sh[0], ks = sh[1], vs = sh[2];
                const float ar = a0c + ((const LAS float*)(lds + A_LAO))[tau * 64 + j];
                const float a = 1.0f / (1.0f + __expf(-ar));
                float kkv = ks * kkc;
                const float n2 = wsum(kkv * kkv);
                kkv = kkv / fmaxf(sqrtf(n2), 1e-12f);
                const float kd = ks * (1.0f + (a - 1.0f) * kac);
                const float bb = kkv * a;
                const float bo = wsum(rs * kd * rkc);
                if (lane == 0) BON[((size_t)d * M + rowbase + tau) * 8 + h] = bo;
                const float cs_ = off + cl[i];
                const float E = __expf(cs_), Ep = __expf(cs_ - lw[i]), Ei = __expf(-cs_);
                const int o2 = sg * MS + 2 * j;
                *(LAS bf16*)(lds + A_KKT + o2) = bf1(kkv * Ep);
                *(LAS bf16*)(lds + A_RT + o2) = bf1(rs * E);
                const float khv = kd * Ei, bhv = bb * Ei;
                *(LAS bf16*)(lds + A_KH + o2) = bf1(khv);
                *(LAS bf16*)(lds + A_BH + o2) = bf1(bhv);
                kht[i] = khv; bht[i] = bhv; vt[i] = vs;
            }
            v4u w;
            w.x = pkbf(kht[0], kht[1]); w.y = pkbf(kht[2], kht[3]); w.z = pkbf(kht[4], kht[5]); w.w = pkbf(kht[6], kht[7]);
            *(LAS v4u*)(lds + A_KHT + j * MS + seg * 16) = w;
            w.x = pkbf(bht[0], bht[1]); w.y = pkbf(bht[2], bht[3]); w.z = pkbf(bht[4], bht[5]); w.w = pkbf(bht[6], bht[7]);
            *(LAS v4u*)(lds + A_BHT + j * MS + seg * 16) = w;
            w.x = pkbf(vt[0], vt[1]); w.y = pkbf(vt[2], vt[3]); w.z = pkbf(vt[4], vt[5]); w.w = pkbf(vt[6], vt[7]);
            *(LAS v4u*)(lds + A_VT + j * MS + seg * 16) = w;
        }
        __syncthreads();
        {
            const int p = wave >> 1;
            const int tside = (p < 2) ? A_KKT : A_RT, sside = (p == 0 || p == 2) ? A_BH : A_KH;
            const int pout = (p == 1) ? A_PKK : (p == 2 ? A_PRB : A_PRK);
#pragma unroll
            for (int q2 = 0; q2 < 2; ++q2) {
                const int tt = (wave & 1) ? (1 + q2) : (3 * q2);
                const bf16x8 t0 = ldsfrag(lds + tside, 16 * tt, 0, lane), t1 = ldsfrag(lds + tside, 16 * tt, 32, lane);
                for (int st = 0; st <= tt; ++st) {
                    const bf16x8 s0 = ldsfrag(lds + sside, 16 * st, 0, lane), s1 = ldsfrag(lds + sside, 16 * st, 32, lane);
                    f32x4 acc = (f32x4){0.f, 0.f, 0.f, 0.f};
                    if (p == 0) {
                        acc = mfma16(t0, s0, acc); acc = mfma16(t1, s1, acc);
                        const int s = 16 * st + l15;
#pragma unroll
                        for (int rg = 0; rg < 4; ++rg) { const int t = 16 * tt + 4 * g + rg;
                            ((LAS float*)(lds + A_LQ))[t * 64 + (s & 3) * 16 + (s >> 2)] = (s < t) ? acc[rg] : 0.f; }
                    } else {
                        acc = mfma16(s0, t0, acc); acc = mfma16(s1, t1, acc);
                        const int t = 16 * tt + l15, sb = 16 * st + 4 * g;
                        float m[4];
#pragma unroll
                        for (int rg = 0; rg < 4; ++rg) { const int s = sb + rg; const bool keep = (p == 1) ? (s < t) : (s <= t); m[rg] = keep ? acc[rg] : 0.f; }
                        v2u w; w.x = pkbf(m[0], m[1]); w.y = pkbf(m[2], m[3]);
                        *(LAS v2u*)(lds + pout + t * MS + sb * 2) = w;
                    }
                }
                if (p != 0 && (tt == 0 || tt == 2)) {
                    *(LAS v2u*)(lds + pout + (16 * tt + l15) * MS + (16 * (tt + 1) + 4 * g) * 2) = (v2u){0u, 0u};
                }
            }
        }
        __syncthreads();
        {
            const int tt = wave >> 1;
#pragma unroll
            for (int q2 = 0; q2 < 2; ++q2) {
                const int vtile = 2 * (wave & 1) + q2;
                f32x4 acc = (f32x4){0.f, 0.f, 0.f, 0.f};
                acc = mfma16(ldsfrag(lds + A_PKK, 16 * tt, 0, lane), ldsfrag(lds + A_VT, 16 * vtile, 0, lane), acc);
                if (tt >= 2) acc = mfma16(ldsfrag(lds + A_PKK, 16 * tt, 32, lane), ldsfrag(lds + A_VT, 16 * vtile, 32, lane), acc);
                LAS float* o = (LAS float*)(lds + A_WP) + (16 * tt + 4 * g) * WPS + 16 * vtile + l15;
#pragma unroll
                for (int rg = 0; rg < 4; ++rg) o[rg * WPS] = acc[rg];
            }
        }
        __syncthreads();
        float X[16];
        {
            const int col = tid >> 2, q = tid & 3;
            float R[16];
#pragma unroll
            for (int m = 0; m < 16; ++m) {
                const int t = 4 * m + q;
                R[m] = (col < 64) ? __uint_as_float((unsigned)(*(const LAS bf16*)(lds + A_KKT + t * MS + col * 2)) << 16)
                                  : ((const LAS float*)(lds + A_WP))[t * WPS + (col - 64)];
                X[m] = 0.f;
            }
            const LAS float* Lq = (const LAS float*)(lds + A_LQ) + q * 16;
#pragma unroll
            for (int t = 0; t < 64; ++t) {
                float part = ((t & 3) == q) ? R[t >> 2] : 0.f;
                const int nm = (t + 3) >> 2;
#pragma unroll
                for (int m4 = 0; m4 < (nm + 3) / 4; ++m4) {
                    const f32x4 lv = *(const LAS f32x4*)(Lq + t * 64 + 4 * m4);
#pragma unroll
                    for (int e = 0; e < 4; ++e) if (4 * m4 + e < nm) part -= lv[e] * X[4 * m4 + e];
                }
                const float tot = quad_sum(part);
                X[t >> 2] = ((t & 3) == q) ? tot : X[t >> 2];
            }
        }
        __syncthreads();
        {
            const int col = tid >> 2, q = tid & 3;
#pragma unroll
            for (int m = 0; m < 16; ++m) *(LAS bf16*)(lds + A_XT + col * MS + (4 * m + q) * 2) = bf1(-X[m]);
        }
        __syncthreads();
        {
            const float* ECp = nullptr; (void)ECp;
            bf16* Mo = Marr + item * 4096; bf16* No = Narr + item * 4096; bf16* Qo = Qarr + item * 4096; bf16* Yo = Yarr + item * 4096;
#pragma unroll
            for (int q2 = 0; q2 < 2; ++q2) {
                const int e = 2 * wave + q2, ra = e >> 2, cb = e & 3;
                {
                    f32x4 acc = (f32x4){0.f, 0.f, 0.f, 0.f};
                    acc = mfma16(ldsfrag(lds + A_XT, 16 * ra, 0, lane), ldsfrag(lds + A_PRB, 16 * cb, 0, lane), acc);
                    if (cb >= 2) acc = mfma16(ldsfrag(lds + A_XT, 16 * ra, 32, lane), ldsfrag(lds + A_PRB, 16 * cb, 32, lane), acc);
                    const int t = 16 * cb + l15, jb = 16 * ra + 4 * g;
                    const v2u rw = *(const LAS v2u*)(lds + A_RT + t * MS + jb * 2);
                    const float r0 = __uint_as_float(rw.x << 16), r1 = __uint_as_float(rw.x & 0xffff0000u), r2 = __uint_as_float(rw.y << 16), r3 = __uint_as_float(rw.y & 0xffff0000u);
                    v2u w; w.x = pkbf(r0 + acc[0], r1 + acc[1]); w.y = pkbf(r2 + acc[2], r3 + acc[3]);
                    *(v2u*)(Qo + t * 64 + jb) = w;
                }
                {
                    f32x4 acc = (f32x4){0.f, 0.f, 0.f, 0.f};
                    acc = mfma16(ldsfrag(lds + A_VT, 16 * ra, 0, lane), ldsfrag(lds + A_PRK, 16 * cb, 0, lane), acc);
                    acc = mfma16(ldsfrag(lds + A_XT, 64 + 16 * ra, 0, lane), ldsfrag(lds + A_PRB, 16 * cb, 0, lane), acc);
                    if (cb >= 2) {
                        acc = mfma16(ldsfrag(lds + A_VT, 16 * ra, 32, lane), ldsfrag(lds + A_PRK, 16 * cb, 32, lane), acc);
                        acc = mfma16(ldsfrag(lds + A_XT, 64 + 16 * ra, 32, lane), ldsfrag(lds + A_PRB, 16 * cb, 32, lane), acc);
                    }
                    const int t = 16 * cb + l15, vb = 16 * ra + 4 * g;
                    v2u w; w.x = pkbf(acc[0], acc[1]); w.y = pkbf(acc[2], acc[3]);
                    *(v2u*)(Yo + t * 64 + vb) = w;
                }
                {
                    f32x4 acc = (f32x4){0.f, 0.f, 0.f, 0.f};
                    acc = mfma16(ldsfrag(lds + A_XT, 16 * ra, 0, lane), ldsfrag(lds + A_BHT, 16 * cb, 0, lane), acc);
                    acc = mfma16(ldsfrag(lds + A_XT, 16 * ra, 32, lane), ldsfrag(lds + A_BHT, 16 * cb, 32, lane), acc);
                    const int jj = 16 * cb + l15, jpb = 16 * ra + 4 * g;
                    const float ec = ((const LAS float*)(lds + A_EC))[jj];
                    float m[4];
#pragma unroll
                    for (int rg = 0; rg < 4; ++rg) m[rg] = ec * (((jpb + rg) == jj ? 1.0f : 0.0f) + acc[rg]);
                    v2u w; w.x = pkbf(m[0], m[1]); w.y = pkbf(m[2], m[3]);
                    *(v2u*)(Mo + jj * 64 + jpb) = w;
                }
                {
                    f32x4 acc = (f32x4){0.f, 0.f, 0.f, 0.f};
#pragma unroll
                    for (int ks = 0; ks < 2; ++ks) {
                        acc = mfma16(ldsfrag(lds + A_KHT, 16 * ra, 32 * ks, lane), ldsfrag(lds + A_VT, 16 * cb, 32 * ks, lane), acc);
                        acc = mfma16(ldsfrag(lds + A_BHT, 16 * ra, 32 * ks, lane), ldsfrag(lds + A_XT, 64 + 16 * cb, 32 * ks, lane), acc);
                    }
                    const int v = 16 * cb + l15, jb = 16 * ra + 4 * g;
                    const f32x4 ec = *(const LAS f32x4*)((const LAS float*)(lds + A_EC) + jb);
                    v2u w; w.x = pkbf(ec[0] * acc[0], ec[1] * acc[1]); w.y = pkbf(ec[2] * acc[2], ec[3] * acc[3]);
                    *(v2u*)(No + v * 64 + jb) = w;
                }
            }
        }
        __syncthreads();
    }
}

__device__ __forceinline__ void rw2b_seq(LAS unsigned char* lds, const bf16* __restrict__ Marr, const bf16* __restrict__ Narr, const bf16* __restrict__ Qarr, bf16* __restrict__ Yarr,
                                         int seq, int vh, int tid, int lane, int wave) {
    const int g = lane >> 4, l15 = lane & 15;
    const int vt = wave & 1, rt = wave >> 1;
    constexpr int HB = 32 * MS;
    for (int u = tid; u < 2 * HB / 4; u += NWAVES * 64) ((LAS unsigned*)lds)[u] = 0u;
    __syncthreads();
    const size_t it0 = (size_t)seq * 64;
    const int offQ = (16 * rt + l15) * 64 + 8 * g;
    const int offY = (16 * rt + l15) * 64 + 32 * vh + 16 * vt + 4 * g;
    const int offN = (32 * vh + 16 * vt + l15) * 64 + 16 * rt + 4 * g;
    bf16x8 q0 = *(const bf16x8*)(Qarr + it0 * 4096 + offQ), q1 = *(const bf16x8*)(Qarr + it0 * 4096 + offQ + 32);
    bf16x8 m0 = *(const bf16x8*)(Marr + it0 * 4096 + offQ), m1 = *(const bf16x8*)(Marr + it0 * 4096 + offQ + 32);
    v2u yl = *(const v2u*)(Yarr + it0 * 4096 + offY), nl = *(const v2u*)(Narr + it0 * 4096 + offN);
    int cur = 0;
#pragma unroll 1
    for (int cs = 0; cs < 64; ++cs) {
        const size_t itn = it0 + (cs < 63 ? cs + 1 : cs);
        const bf16x8 nq0 = *(const bf16x8*)(Qarr + itn * 4096 + offQ), nq1 = *(const bf16x8*)(Qarr + itn * 4096 + offQ + 32);
        const bf16x8 nm0 = *(const bf16x8*)(Marr + itn * 4096 + offQ), nm1 = *(const bf16x8*)(Marr + itn * 4096 + offQ + 32);
        const v2u nyl = *(const v2u*)(Yarr + itn * 4096 + offY), nnl = *(const v2u*)(Narr + itn * 4096 + offN);
        const LAS unsigned char* hb = lds + cur * HB;
        const bf16x8 h0 = ldsfrag(hb, 16 * vt, 0, lane), h1 = ldsfrag(hb, 16 * vt, 32, lane);
        f32x4 ya; ya[0] = __uint_as_float(yl.x << 16); ya[1] = __uint_as_float(yl.x & 0xffff0000u); ya[2] = __uint_as_float(yl.y << 16); ya[3] = __uint_as_float(yl.y & 0xffff0000u);
        ya = mfma16(h0, q0, ya); ya = mfma16(h1, q1, ya);
        f32x4 ha; ha[0] = __uint_as_float(nl.x << 16); ha[1] = __uint_as_float(nl.x & 0xffff0000u); ha[2] = __uint_as_float(nl.y << 16); ha[3] = __uint_as_float(nl.y & 0xffff0000u);
        ha = mfma16(m0, h0, ha); ha = mfma16(m1, h1, ha);
        { v2u w; w.x = pkbf(ya[0], ya[1]); w.y = pkbf(ya[2], ya[3]); *(v2u*)(Yarr + (it0 + cs) * 4096 + offY) = w; }
        { v2u w; w.x = pkbf(ha[0], ha[1]); w.y = pkbf(ha[2], ha[3]); *(LAS v2u*)(lds + (cur ^ 1) * HB + (16 * vt + l15) * MS + (16 * rt + 4 * g) * 2) = w; }
        __syncthreads();
        cur ^= 1; q0 = nq0; q1 = nq1; m0 = nm0; m1 = nm1; yl = nyl; nl = nnl;
    }
}
constexpr int HS = 272;
constexpr int H_QT = 0, H_KT = 17408, H_KTT = 34816, H_VT = 53248, H_P = 57856, H_ST = 67072, H_G = 84480, H_SEG = 84992, H_END = 87040;
__device__ __forceinline__ bf16x8 ldsfrag_s(LAS const unsigned char* base, int row0, int k0, int lane, int stride) {
    return *(const LAS bf16x8*)(base + (row0 + (lane & 15)) * stride + (k0 + 8 * (lane >> 4)) * 2);
}
__device__ __forceinline__ void hg_seq(LAS unsigned char* lds, const bf16* __restrict__ P, bf16* __restrict__ OHG, int seq, int sl, int tid, int lane, int wave) {
    const int g = lane >> 4, l15 = lane & 15;
    const int h = seq & 3, b = (seq >> 2) & 3, d = seq >> 4;
    for (int u = tid; u < 2 * 8704 / 4; u += NWAVES * 64) ((LAS unsigned*)(lds + H_ST))[u] = 0u;
    const int ek = tid & 127, eseg = tid >> 7;
    const int vv = tid & 31, vgrp = tid >> 5;
    const bf16* pq = P + RW_COLS + h * 128 + ek;
    const bf16* pk = P + RW_COLS + 512 + d * 512 + h * 128 + ek;
    const bf16* pv = P + RW_COLS + 1536 + h * 128 + 32 * sl + vv;
    f32x4 S0 = (f32x4){0.f, 0.f, 0.f, 0.f}, S1 = (f32x4){0.f, 0.f, 0.f, 0.f};
    unsigned short kraw[16], qraw[16], vraw[4];
    {
        const size_t rb = (size_t)b * T + (size_t)(d ? 63 : 0) * 64;
#pragma unroll
        for (int i = 0; i < 16; ++i) { const int sg = 16 * eseg + i, tau = d ? 63 - sg : sg; kraw[i] = pk[(rb + tau) * IN_COLS]; qraw[i] = pq[(rb + tau) * IN_COLS]; }
#pragma unroll
        for (int i = 0; i < 4; ++i) { const int sg = 4 * vgrp + i, tau = d ? 63 - sg : sg; vraw[i] = pv[(rb + tau) * IN_COLS]; }
    }
    __syncthreads();
    int cur = 0;
#pragma unroll 1
    for (int cs = 0; cs < 64; ++cs) {
        const int cn = d ? 63 - cs : cs;
        const size_t rowbase = (size_t)b * T + (size_t)cn * 64;
        float Eseg[16], kv[16];
        {
            float run = 1.f;
#pragma unroll
            for (int i = 0; i < 16; ++i) { kv[i] = __uint_as_float((unsigned)kraw[i] << 16); run *= (1.0f - kv[i]); Eseg[i] = run; }
            ((LAS float*)(lds + H_SEG))[eseg * 128 + ek] = run;
            v2u w; w.x = (unsigned)vraw[0] | ((unsigned)vraw[1] << 16); w.y = (unsigned)vraw[2] | ((unsigned)vraw[3] << 16);
            *(LAS v2u*)(lds + H_VT + vv * MS + vgrp * 8) = w;
        }
        __syncthreads();
        {
            float pre = 1.f;
#pragma unroll
            for (int s4 = 0; s4 < 3; ++s4) { const float v = ((const LAS float*)(lds + H_SEG))[s4 * 128 + ek]; if (s4 < eseg) pre *= v; }
            if (eseg == 3) ((LAS float*)(lds + H_G))[ek] = pre * Eseg[15];
            float ktt[16];
#pragma unroll
            for (int i = 0; i < 16; ++i) {
                const int sg = 16 * eseg + i;
                const float E = fmaxf(pre * Eseg[i], 1e-30f), Ei = __builtin_amdgcn_rcpf(E);
                const float qv = __uint_as_float((unsigned)qraw[i] << 16);
                const float kt = kv[i] * Ei;
                *(LAS bf16*)(lds + H_QT + sg * HS + 2 * ek) = bf1(qv * E);
                *(LAS bf16*)(lds + H_KT + sg * HS + 2 * ek) = bf1(kt);
                ktt[i] = kt;
            }
            v4u w;
            w.x = pkbf(ktt[0], ktt[1]); w.y = pkbf(ktt[2], ktt[3]); w.z = pkbf(ktt[4], ktt[5]); w.w = pkbf(ktt[6], ktt[7]);
            *(LAS v4u*)(lds + H_KTT + ek * MS + eseg * 32) = w;
            w.x = pkbf(ktt[8], ktt[9]); w.y = pkbf(ktt[10], ktt[11]); w.z = pkbf(ktt[12], ktt[13]); w.w = pkbf(ktt[14], ktt[15]);
            *(LAS v4u*)(lds + H_KTT + ek * MS + eseg * 32 + 16) = w;
        }
        if (cs < 63) {
            const int cn2 = d ? 62 - cs : cs + 1;
            const size_t rb = (size_t)b * T + (size_t)cn2 * 64;
#pragma unroll
            for (int i = 0; i < 16; ++i) { const int sg = 16 * eseg + i, tau = d ? 63 - sg : sg; kraw[i] = pk[(rb + tau) * IN_COLS]; qraw[i] = pq[(rb + tau) * IN_COLS]; }
#pragma unroll
            for (int i = 0; i < 4; ++i) { const int sg = 4 * vgrp + i, tau = d ? 63 - sg : sg; vraw[i] = pv[(rb + tau) * IN_COLS]; }
        }
        __syncthreads();
        {
#pragma unroll
            for (int q2 = 0; q2 < 2; ++q2) {
                const int id = wave + 8 * q2;
                if (id < 10) {
                    const int tt = (int)((0x3333222110ull >> (4 * id)) & 15ull), st = (int)((0x3210210100ull >> (4 * id)) & 15ull);
                    f32x4 acc = (f32x4){0.f, 0.f, 0.f, 0.f};
#pragma unroll
                    for (int kk = 0; kk < 4; ++kk) acc = mfma16(ldsfrag_s(lds + H_KT, 16 * st, 32 * kk, lane, HS), ldsfrag_s(lds + H_QT, 16 * tt, 32 * kk, lane, HS), acc);
                    const int t = 16 * tt + l15, sb = 16 * st + 4 * g;
                    float m[4];
#pragma unroll
                    for (int rg = 0; rg < 4; ++rg) m[rg] = (sb + rg <= t) ? acc[rg] : 0.f;
                    v2u w; w.x = pkbf(m[0], m[1]); w.y = pkbf(m[2], m[3]);
                    *(LAS v2u*)(lds + H_P + t * MS + sb * 2) = w;
                }
            }
            if (wave == 2 || wave == 3) { const int tt = (wave == 2) ? 0 : 2;
                *(LAS v2u*)(lds + H_P + (16 * tt + l15) * MS + (16 * (tt + 1) + 4 * g) * 2) = (v2u){0u, 0u}; }
        }
        __syncthreads();
        {
            const int vt = wave & 1, tt = wave >> 1;
            f32x4 acc = (f32x4){0.f, 0.f, 0.f, 0.f};
            acc = mfma16(ldsfrag_s(lds + H_VT, 16 * vt, 0, lane, MS), ldsfrag_s(lds + H_P, 16 * tt, 0, lane, MS), acc);
            if (tt >= 2) acc = mfma16(ldsfrag_s(lds + H_VT, 16 * vt, 32, lane, MS), ldsfrag_s(lds + H_P, 16 * tt, 32, lane, MS), acc);
#pragma unroll
            for (int kk = 0; kk < 4; ++kk) acc = mfma16(ldsfrag_s(lds + H_ST + cur * 8704, 16 * vt, 32 * kk, lane, HS), ldsfrag_s(lds + H_QT, 16 * tt, 32 * kk, lane, HS), acc);
            const int t = 16 * tt + l15, tau = d ? 63 - t : t;
            v2u w; w.x = pkbf(acc[0], acc[1]); w.y = pkbf(acc[2], acc[3]);
            *(v2u*)(OHG + ((size_t)d * M + rowbase + tau) * 512 + h * 128 + 32 * sl + 16 * vt + 4 * g) = w;
        }
        {
            const bf16x8 a0 = ldsfrag_s(lds + H_KTT, 16 * wave, 0, lane, MS), a1 = ldsfrag_s(lds + H_KTT, 16 * wave, 32, lane, MS);
            S0 = mfma16(a0, ldsfrag_s(lds + H_VT, 0, 0, lane, MS), S0); S0 = mfma16(a1, ldsfrag_s(lds + H_VT, 0, 32, lane, MS), S0);
            S1 = mfma16(a0, ldsfrag_s(lds + H_VT, 16, 0, lane, MS), S1); S1 = mfma16(a1, ldsfrag_s(lds + H_VT, 16, 32, lane, MS), S1);
            const f32x4 gv = *(const LAS f32x4*)((const LAS float*)(lds + H_G) + 16 * wave + 4 * g);
            S0 = S0 * gv; S1 = S1 * gv;
            LAS unsigned char* sn = lds + H_ST + (cur ^ 1) * 8704;
            v2u w; w.x = pkbf(S0[0], S0[1]); w.y = pkbf(S0[2], S0[3]);
            *(LAS v2u*)(sn + l15 * HS + (16 * wave + 4 * g) * 2) = w;
            w.x = pkbf(S1[0], S1[1]); w.y = pkbf(S1[2], S1[3]);
            *(LAS v2u*)(sn + (16 + l15) * HS + (16 * wave + 4 * g) * 2) = w;
        }
        __syncthreads();
        cur ^= 1;
    }
}
struct Args { const float* in[18]; float* out; unsigned char* ws; int ph_lo, ph_hi; };
__global__ void __launch_bounds__(NWAVES * 64, 2) mega(Args args) {
    extern __shared__ __attribute__((aligned(16))) unsigned char lds_raw[];
    LAS unsigned char* lds = (LAS unsigned char*)lds_raw;
    volatile LAS unsigned* MISC = (volatile LAS unsigned*)(lds + MISC_OFF);
    const int tid = threadIdx.x, lane = tid & 63, wave = __builtin_amdgcn_readfirstlane(tid >> 6);
    const int G = gridDim.x;
    const int vcu = (G % 8 == 0) ? ((int)blockIdx.x % 8) * (G / 8) + (int)blockIdx.x / 8 : (int)blockIdx.x;
    unsigned char* ws = args.ws;
    gu32* ctl = (gu32*)(ws + WS_CTL);
    for (int u = tid; u < (LDS_BYTES - LDSCTL_OFF) / 4; u += NWAVES * 64) ((LAS unsigned*)(lds + LDSCTL_OFF))[u] = 0u;
    __syncthreads();
    XcdBarrier bar = xcd_barrier_post((unsigned*)(ctl + CW_BAR), MISC + 8);
    const int lo = args.ph_lo, hi = args.ph_hi;
#define IN(k) (lo <= (k) && (k) < hi)
#define BOTH(k) (IN(k) && IN((k) + 1))
    const float* x = args.in[0]; const float* pre_g = args.in[1]; const float* w_in = args.in[2]; const float* w_out = args.in[16];
    bf16* P = (bf16*)(ws + WS_P); bf16* XN = (bf16*)(ws + WS_XN); bf16* WIN_T = (bf16*)(ws + WS_WIN); bf16* WOUT_T = (bf16*)(ws + WS_WOUT); bf16* W2T = (bf16*)(ws + WS_W2T); bf16* A2T = (bf16*)(ws + WS_A2T);
    bf16* Marr = (bf16*)args.out; bf16* Narr = (bf16*)args.out + (size_t)16 * 1024 * 1024; bf16* Qarr = (bf16*)(ws + WS_Q); bf16* Yarr = (bf16*)(ws + WS_Y); bf16* OHG = (bf16*)(ws + WS_OHG);

    if (IN(0)) {
        LAS float* scr = (LAS float*)(lds + RING_OFF + wave * 16384);
        const int gw = vcu * NWAVES + wave, NGW = G * NWAVES;
        constexpr int I_IN = (D / 64) * (IN_COLS / 32), I_OUT = (D / 64) * (D / 32);
        for (int it = gw; it < I_IN + I_OUT; it += NGW) {
            if (it < I_IN) p0_transpose_item(w_in, D, IN_COLS, WIN_T, scr, it, lane);
            else p0_transpose_item(w_out, D, D, WOUT_T, scr, it - I_IN, lane);
        }
        for (int it = gw; it < 64; it += NGW) {
            const int which = it >> 5, dd = (it >> 4) & 1, sub = it & 15;
            p0_transpose_item(args.in[which ? 8 : 6] + (size_t)dd * 64 * 512, 64, 512, (which ? A2T : W2T) + (size_t)dd * 512 * 64, scr, sub, lane);
        }
        for (int m = gw; m < M; m += NGW) rms_row_to_bf16(x + (size_t)m * D, pre_g, XN + (size_t)m * D, lane);
        if (BOTH(0)) xcd_barrier(bar);
    }
    if (IN(1)) {
        pg8::Gemm g{XN, WIN_T, M, IN_COLS, D}; pg8::StaticOrder S; S.init(M, IN_COLS, G, (int)blockIdx.x);
        pg8::EpiP E{P, IN_COLS, args.in[14]};
        pg8::gemm_phase<pg8::EpiP, pg8::StaticOrder, PG8_ALIGN, PG8_SP2>(lds + RING_OFF, g, S, E);
        if (BOTH(1)) xcd_barrier(bar);
    }
    float* BON = (float*)(ws + WS_BON); bf16* YMIX = Qarr; float* Y = args.out;
    if (IN(2)) {
        for (int i = 0; i < 8; ++i) { const int wi = vcu * 8 + i; rw2a_item(lds, P, args.in, W2T, A2T, Marr, Narr, Qarr, Yarr, BON, wi >> 9, (wi >> 6) & 7, wi & 63, tid, lane, wave); }
        if (BOTH(2)) xcd_barrier(bar);
    }
    if (IN(3)) {
        if (vcu < 128) rw2b_seq(lds, Marr, Narr, Qarr, Yarr, vcu >> 1, vcu & 1, tid, lane, wave);
        else hg_seq(lds, P, OHG, (vcu - 128) >> 2, (vcu - 128) & 3, tid, lane, wave);
        if (BOTH(3)) xcd_barrier(bar);
    }
    if (IN(4)) {
        const int gw = vcu * NWAVES + wave, NGW = G * NWAVES;
        for (int m = gw; m < M; m += NGW) mix_row(P, args.in, Yarr, BON, OHG, YMIX, m, lane);
        if (BOTH(4)) xcd_barrier(bar);
    }
    if (IN(5)) {
        pg8::Gemm g{YMIX, WOUT_T, M, D, D}; pg8::StaticOrder S; S.init(M, D, G, (int)blockIdx.x);
        pg8::EpiF32 E{Y, D, nullptr};
        pg8::gemm_phase<pg8::EpiF32, pg8::StaticOrder, PG8_ALIGN, PG8_SP2>(lds + RING_OFF, g, S, E);
        if (BOTH(5)) xcd_barrier(bar);
    }
    if (IN(6)) {
        const int gw = vcu * NWAVES + wave, NGW = G * NWAVES;
        for (int m = gw; m < M; m += NGW) post_row(x + (size_t)m * D, Y + (size_t)m * D, args.in[17], args.out + (size_t)m * D, lane);
    }
#undef IN
#undef BOTH
}
extern "C" void kernel_launch(void* const* d_in, const int* in_sizes, int n_in, void* d_out, int out_size, void* d_ws, size_t ws_size, hipStream_t stream) {
    static int grid = 0;
    if (grid == 0) {
        int dev = 0, cus = 0;
        if (hipGetDevice(&dev) != hipSuccess || hipDeviceGetAttribute(&cus, hipDeviceAttributeMultiprocessorCount, dev) != hipSuccess) { fprintf(stderr, "kernel_launch: device query failed\n"); grid = -1; return; }
        if (hipFuncSetAttribute((const void*)mega, hipFuncAttributeMaxDynamicSharedMemorySize, LDS_BYTES) != hipSuccess) { fprintf(stderr, "kernel_launch: hipFuncSetAttribute failed\n"); grid = -1; return; }
        (void)hipGetLastError();
        grid = cus;
    }
    if (grid < 0) return;
    (void)hipMemsetAsync((char*)d_ws + WS_CTL, 0, CTL_ZERO_BYTES, stream);
    Args a{};
    for (int i = 0; i < 18; ++i) a.in[i] = (const float*)d_in[i];
    a.out = (float*)d_out; a.ws = (unsigned char*)d_ws; a.ph_lo = 0; a.ph_hi = 7;
    hipLaunchKernelGGL(mega, dim3(grid), dim3(NWAVES * 64), LDS_BYTES, stream, a);
}
```

```cpp
#include <hip/hip_runtime.h>
#include <cstdio>
#include <cstdint>
namespace pg8 {
#define PG8_LAS __attribute__((address_space(3)))
typedef unsigned short bf16_t;
typedef short bf16x8 __attribute__((ext_vector_type(8)));
typedef float f32x4 __attribute__((ext_vector_type(4)));
typedef unsigned u32x4 __attribute__((ext_vector_type(4)));
constexpr int BM = 256, BK = 64, HALF = 128, HTB = HALF * BK * 2  , STAGE_BYTES = 8 * HTB, NXCD = 8, WGM = 8;

__host__ __device__ __forceinline__ int lds_byte(int r, int c) { const int st = (r >> 4) * 2 + (c >> 5), rr = r & 15, cc = c & 31, ob = rr * 64 + cc * 2; return st * 1024 + (ob ^ (((ob >> 9) & 1) << 5)); }
__host__ __device__ __forceinline__ void stage_rc(int b, int& R, int& C) { const int st = b / 1024, sb = b % 1024, swz = sb ^ (((sb >> 9) & 1) << 5); R = (st >> 1) * 16 + swz / 64; C = (st & 1) * 32 + (swz % 64) / 2; }
__host__ __device__ __forceinline__ int perm32(int rho) { const int n = rho >> 4, i = rho & 15; return 8 * (i >> 2) + 4 * n + (i & 3); }

struct Unit { int pm, pn; };
struct Gemm { const bf16_t* A; const bf16_t* Bt; int M, N, K; };

struct StaticOrder {
    int nM, nN, nwg, G, c;
    __host__ __device__ void init(int M, int N, int G_, int c_) { nM = M / BM; nN = N / BM; nwg = nM * nN; G = G_; c = c_; }
    __host__ __device__ bool next(int i, Unit& u) const {
        const long L = (long)i * G + c; if (L >= nwg) return false;
        int wgid = (int)L; { const int q = nwg / NXCD, r = nwg % NXCD, xcd = wgid % NXCD, off = wgid / NXCD; wgid = (xcd < r ? xcd * (q + 1) : r * (q + 1) + (xcd - r) * q) + off; }
        const int nig = WGM * nN, gid = wgid / nig, fm = gid * WGM, gsz = (nM - fm) < WGM ? (nM - fm) : WGM;
        u.pm = fm + ((wgid % nig) % gsz); u.pn = (wgid % nig) / gsz; return true;
    }
    __device__ __forceinline__ void a_ready(const Unit&) const {}
    __device__ __forceinline__ void done(const Unit&) const {}
};

__device__ __forceinline__ unsigned cvt_pk_bf16(float lo, float hi) { unsigned r; asm volatile("v_cvt_pk_bf16_f32 %0, %1, %2" : "=v"(r) : "v"(lo), "v"(hi)); return r; }
typedef float f32x2 __attribute__((ext_vector_type(2)));
__device__ __forceinline__ f32x2 gelu_pk(f32x2 v) {
    const f32x2 av = __builtin_elementwise_abs(v), d = av * 0.2316418882f + 1.0f;
    f32x2 t; t.x = __builtin_amdgcn_rcpf(d.x); t.y = __builtin_amdgcn_rcpf(d.y);
    f32x2 q = t * 0.5307027145f + (-0.7265760135f); q = q * t + 0.7107068705f; q = q * t + (-0.142248368f); q = q * t + 0.127414796f; q = q * t;
    const f32x2 s = (v * v) * (-0.72134752044f);
    f32x2 e; e.x = __builtin_amdgcn_exp2f(s.x); e.y = __builtin_amdgcn_exp2f(s.y);
    const f32x2 m = v * (q * e), r = v - m;
    f32x2 o; o.x = v.x < 0.f ? m.x : r.x; o.y = v.y < 0.f ? m.y : r.y; return o;
}

template <int ACT  > struct EpiBf16 {
    static constexpr bool PERM = true, AFTER_DRAIN = false; static_assert(ACT == 0 || ACT == 1, "EpiBf16: ACT is 0 (none) or 1 (gelu_pk)");
    bf16_t* O; int ldc; const float* bias; int split_cols; size_t split_stride; float scale0;
    __device__ __forceinline__ void operator()(const f32x4 (&acc)[2][2][4][2], const Unit& u, int wr, int wc, int fr, int fq) const {
        const int row0 = u.pm * BM + wr * 64 + fr; int colt = u.pn * BM; bf16_t* base = O;
        float sc = 1.f; if (split_cols) { const int t = colt / split_cols; base += (size_t)t * split_stride; colt -= t * split_cols; if (t == 0) sc = scale0; }
        const int col0 = colt + wc * 32 + 8 * fq, bcol0 = u.pn * BM + wc * 32 + 8 * fq;
        f32x4 bv[2][2];
#pragma unroll
        for (int bj = 0; bj < 2; ++bj)
#pragma unroll
            for (int n = 0; n < 2; ++n) bv[bj][n] = bias ? *(const f32x4*)(bias + bcol0 + bj * HALF + 4 * n) : (f32x4){0.f, 0.f, 0.f, 0.f};
#pragma unroll
        for (int ai = 0; ai < 2; ++ai)
#pragma unroll
            for (int m = 0; m < 4; ++m) { bf16_t* rowp = base + (size_t)(row0 + ai * HALF + m * 16) * ldc + col0;
#pragma unroll
                for (int bj = 0; bj < 2; ++bj) { f32x4 v0 = acc[ai][bj][m][0] + bv[bj][0], v1 = acc[ai][bj][m][1] + bv[bj][1];
                    if (ACT == 1) { f32x2 a = gelu_pk((f32x2){v0[0], v0[1]}), b = gelu_pk((f32x2){v0[2], v0[3]}), c = gelu_pk((f32x2){v1[0], v1[1]}), d = gelu_pk((f32x2){v1[2], v1[3]});
                        v0 = (f32x4){a.x, a.y, b.x, b.y}; v1 = (f32x4){c.x, c.y, d.x, d.y}; }
                    v0 = v0 * sc; v1 = v1 * sc; u32x4 w; w.x = cvt_pk_bf16(v0[0], v0[1]); w.y = cvt_pk_bf16(v0[2], v0[3]); w.z = cvt_pk_bf16(v1[0], v1[1]); w.w = cvt_pk_bf16(v1[2], v1[3]);
                    *(u32x4*)(rowp + bj * HALF) = w; } }
    }
};
struct EpiF32 {
    static constexpr bool PERM = false, AFTER_DRAIN = false;
    float* C; int ldc; const float* bias;
    __device__ __forceinline__ void operator()(const f32x4 (&acc)[2][2][4][2], const Unit& u, int wr, int wc, int fr, int fq) const {
        const int row0 = u.pm * BM + wr * 64 + fr, col0 = u.pn * BM + wc * 32 + 4 * fq;
        f32x4 bv[2][2];
#pragma unroll
        for (int bj = 0; bj < 2; ++bj)
#pragma unroll
            for (int n = 0; n < 2; ++n) bv[bj][n] = bias ? *(const f32x4*)(bias + col0 + bj * HALF + n * 16) : (f32x4){0.f, 0.f, 0.f, 0.f};
#pragma unroll
        for (int ai = 0; ai < 2; ++ai)
#pragma unroll
            for (int m = 0; m < 4; ++m) { float* rowp = C + (size_t)(row0 + ai * HALF + m * 16) * ldc + col0;
#pragma unroll
                for (int bj = 0; bj < 2; ++bj)
#pragma unroll
                    for (int n = 0; n < 2; ++n) *(f32x4*)(rowp + bj * HALF + n * 16) = acc[ai][bj][m][n] + bv[bj][n]; }
    }
};
struct EpiP {
    static constexpr bool PERM = true, AFTER_DRAIN = false;
    bf16_t* O; int ldc; const float* lbl;
    __device__ __forceinline__ void operator()(const f32x4 (&acc)[2][2][4][2], const Unit& u, int wr, int wc, int fr, int fq) const {
        const int row0 = u.pm * BM + wr * 64 + fr, col0 = u.pn * BM + wc * 32 + 8 * fq;
        const int mode = (u.pn >= 11 && u.pn <= 14) ? 1 : (u.pn >= 17 ? 2 : 0);
        f32x4 om[2][2];
#pragma unroll
        for (int bj = 0; bj < 2; ++bj)
#pragma unroll
            for (int n = 0; n < 2; ++n) {
                om[bj][n] = (f32x4){1.f, 1.f, 1.f, 1.f};
                if (mode == 1) { const int ch = (col0 + bj * HALF + 4 * n - 2816) & 511;
                    const f32x4 l0 = *(const f32x4*)(lbl + ch), l1 = *(const f32x4*)(lbl + 512 + ch);
#pragma unroll
                    for (int e = 0; e < 4; ++e) om[bj][n][e] = 1.0f - 1.0f / (1.0f + __expf(-(l0[e] - l1[e]))); }
            }
#pragma unroll
        for (int ai = 0; ai < 2; ++ai)
#pragma unroll
            for (int m = 0; m < 4; ++m) { bf16_t* rowp = O + (size_t)(row0 + ai * HALF + m * 16) * ldc + col0;
#pragma unroll
                for (int bj = 0; bj < 2; ++bj) { f32x4 v0 = acc[ai][bj][m][0], v1 = acc[ai][bj][m][1];
                    if (mode == 1) {
#pragma unroll
                        for (int e = 0; e < 4; ++e) { v0[e] = om[bj][0][e] / (1.0f + __expf(v0[e])); v1[e] = om[bj][1][e] / (1.0f + __expf(v1[e])); } }
                    else if (mode == 2) {
#pragma unroll
                        for (int e = 0; e < 4; ++e) { v0[e] = v0[e] / (1.0f + __expf(-v0[e])); v1[e] = v1[e] / (1.0f + __expf(-v1[e])); } }
                    u32x4 w; w.x = cvt_pk_bf16(v0[0], v0[1]); w.y = cvt_pk_bf16(v0[2], v0[3]); w.z = cvt_pk_bf16(v1[0], v1[1]); w.w = cvt_pk_bf16(v1[2], v1[3]);
                    *(u32x4*)(rowp + bj * HALF) = w; } }
    }
};
template <class Epi, class Sched, bool ALIGN_EPI = false, bool SP2 = false>
__device__ __forceinline__ void gemm_phase(PG8_LAS unsigned char* lds, const Gemm g, const Sched& S, const Epi& E) {
    const int tid = threadIdx.x, wid = __builtin_amdgcn_readfirstlane(tid >> 6), lane = tid & 63, wr = wid >> 2, wc = wid & 3, fr = lane & 15, fq = lane >> 4;
    const int K = g.K, nt = K / BK;
    unsigned voffA[2], voffB[2];
#pragma unroll
    for (int i = 0; i < 2; ++i) { int R, C; stage_rc(tid * 16 + i * 8192, R, C); const int Rb = Epi::PERM ? ((R & ~31) + perm32(R & 31)) : R;
        voffA[i] = (unsigned)(R * K + C) * 2u; voffB[i] = (unsigned)(Rb * K + C) * 2u; }
    const size_t kstep = (size_t)(BK * 2);
    const size_t hstep = (size_t)HALF * K * 2;
    const size_t tstep = 2 * hstep;
    const unsigned ldsw = (unsigned)wid * 1024u;
    const int aoff = lds_byte(wr * 64 + fr, fq * 8), boff = lds_byte(wc * 32 + fr, fq * 8);
#define PG8_SA(b, h) (((b) * 2 + (h)) * HTB)
#define PG8_SB(b, h) ((4 + (b) * 2 + (h)) * HTB)
#define PG8_STAGE(bufoff, gbase, voff) do { _Pragma("unroll") for (int _i = 0; _i < 2; ++_i) \
        __builtin_amdgcn_global_load_lds((const unsigned*)((const char*)(gbase) + (voff)[_i]), (PG8_LAS unsigned*)(lds + (bufoff) + ldsw + _i * 8192), 16, 0, 0); } while (0)
#define PG8_LDA(dst, b, h) do { _Pragma("unroll") for (int m = 0; m < 4; ++m) _Pragma("unroll") for (int k = 0; k < 2; ++k) dst[m][k] = *(const PG8_LAS bf16x8*)(lds + PG8_SA(b, h) + aoff + m * 2048 + k * 1024); } while (0)
#define PG8_LDB(dst, b, h) do { _Pragma("unroll") for (int n = 0; n < 2; ++n) _Pragma("unroll") for (int k = 0; k < 2; ++k) dst[n][k] = *(const PG8_LAS bf16x8*)(lds + PG8_SB(b, h) + boff + n * 2048 + k * 1024); } while (0)
#define PG8_MMA(ai, bj, At, Bt) do { __builtin_amdgcn_s_setprio(1); _Pragma("unroll") for (int m = 0; m < 4; ++m) _Pragma("unroll") for (int n = 0; n < 2; ++n) _Pragma("unroll") for (int k = 0; k < 2; ++k) \
        acc[ai][bj][m][n] = __builtin_amdgcn_mfma_f32_16x16x32_bf16(Bt[n][k], At[m][k], acc[ai][bj][m][n], 0, 0, 0); __builtin_amdgcn_s_setprio(0); } while (0)
#define PG8_WAIT_V(n) asm volatile("s_waitcnt vmcnt(" #n ")" ::: "memory")
#define PG8_WAIT_L(n) asm volatile("s_waitcnt lgkmcnt(" #n ")" ::: "memory")
#define PG8_BAR __builtin_amdgcn_s_barrier()
#define PG8_SCHED __builtin_amdgcn_sched_barrier(0)
    Unit cur, nxt; int ui = 0;
    if (!S.next(0, cur)) return;
    f32x4 acc[2][2][4][2];
#pragma unroll
    for (int a = 0; a < 2; ++a)
#pragma unroll
        for (int b = 0; b < 2; ++b)
#pragma unroll
            for (int m = 0; m < 4; ++m)
#pragma unroll
                for (int n = 0; n < 2; ++n) acc[a][b][m][n] = (f32x4){0.f, 0.f, 0.f, 0.f};
    bf16x8 At[4][2], B0[2][2], B1[2][2];
    const char* cA = (const char*)g.A + (size_t)cur.pm * tstep; const char* cB = (const char*)g.Bt + (size_t)cur.pn * tstep;
    S.a_ready(cur);
    if constexpr (SP2) {
        PG8_STAGE(PG8_SB(0, 0), cB, voffB); PG8_STAGE(PG8_SB(0, 1), cB + hstep, voffB); PG8_STAGE(PG8_SA(0, 0), cA, voffA); PG8_STAGE(PG8_SA(0, 1), cA + hstep, voffA);
        if (wr == 1) PG8_BAR;
        PG8_WAIT_V(2); PG8_BAR;
        PG8_STAGE(PG8_SB(1, 0), cB + kstep, voffB); PG8_STAGE(PG8_SA(1, 0), cA + kstep, voffA); PG8_STAGE(PG8_SB(1, 1), cB + hstep + kstep, voffB);
        PG8_WAIT_V(6); PG8_BAR;
    } else {
        PG8_STAGE(PG8_SB(0, 0), cB, voffB); PG8_STAGE(PG8_SA(0, 0), cA, voffA); PG8_STAGE(PG8_SB(0, 1), cB + hstep, voffB); PG8_STAGE(PG8_SA(0, 1), cA + hstep, voffA);
        if (wr == 1) PG8_BAR;
        PG8_WAIT_V(4); PG8_BAR;
        PG8_STAGE(PG8_SB(1, 0), cB + kstep, voffB); PG8_STAGE(PG8_SA(1, 0), cA + kstep, voffA); PG8_STAGE(PG8_SB(1, 1), cB + hstep + kstep, voffB);
        PG8_WAIT_V(6); PG8_BAR;
    }
    for (;;) {
        const bool has_next = S.next(ui + 1, nxt);
        const char* nA = has_next ? (const char*)g.A + (size_t)nxt.pm * tstep : cA; const char* nB = has_next ? (const char*)g.Bt + (size_t)nxt.pn * tstep : cB;
        for (int t = 0; t < nt; t += 2) {
            const bool last = (t == nt - 2);
            const char* a1 = cA + (size_t)(t + 1) * kstep;
            const char* a2 = last ? nA : cA + (size_t)(t + 2) * kstep; const char* b2 = last ? nB : cB + (size_t)(t + 2) * kstep;
            const char* a3 = a2 + kstep; const char* b3 = b2 + kstep;
            if (last && has_next) S.a_ready(nxt);
            if constexpr (SP2) {
            PG8_LDB(B0, 0, 0); PG8_LDB(B1, 0, 1); PG8_SCHED; PG8_LDA(At, 0, 0); PG8_STAGE(PG8_SA(1, 1), a1 + hstep, voffA);
            PG8_WAIT_V(8); PG8_WAIT_L(0); PG8_BAR; PG8_MMA(0, 0, At, B0); PG8_MMA(0, 1, At, B1); PG8_BAR; PG8_SCHED;
            PG8_LDA(At, 0, 1); PG8_STAGE(PG8_SB(0, 0), b2, voffB); PG8_STAGE(PG8_SB(0, 1), b2 + hstep, voffB); PG8_STAGE(PG8_SA(0, 0), a2, voffA);
            PG8_WAIT_V(8); PG8_WAIT_L(0); PG8_BAR; PG8_MMA(1, 0, At, B0); PG8_MMA(1, 1, At, B1); PG8_BAR; PG8_SCHED;
            PG8_LDB(B0, 1, 0); PG8_LDB(B1, 1, 1); PG8_SCHED; PG8_LDA(At, 1, 0); PG8_STAGE(PG8_SA(0, 1), a2 + hstep, voffA);
            PG8_WAIT_V(8); PG8_WAIT_L(0); PG8_BAR; PG8_MMA(0, 0, At, B0); PG8_MMA(0, 1, At, B1); PG8_BAR; PG8_SCHED;
            PG8_LDA(At, 1, 1); PG8_STAGE(PG8_SB(1, 0), b3, voffB); PG8_STAGE(PG8_SB(1, 1), b3 + hstep, voffB); PG8_STAGE(PG8_SA(1, 0), a3, voffA);
            PG8_WAIT_V(8); PG8_WAIT_L(0); PG8_BAR; PG8_MMA(1, 0, At, B0); PG8_MMA(1, 1, At, B1); PG8_BAR; PG8_SCHED;
            } else {
            PG8_LDB(B0, 0, 0); PG8_SCHED; PG8_LDA(At, 0, 0); PG8_STAGE(PG8_SA(1, 1), a1 + hstep, voffA);
            PG8_WAIT_L(8); PG8_BAR; PG8_WAIT_L(0); PG8_MMA(0, 0, At, B0); PG8_BAR; PG8_SCHED;
            PG8_LDB(B1, 0, 1); PG8_STAGE(PG8_SB(0, 0), b2, voffB);
            PG8_BAR; PG8_WAIT_L(0); PG8_MMA(0, 1, At, B1); PG8_BAR;
            PG8_LDA(At, 0, 1); PG8_STAGE(PG8_SA(0, 0), a2, voffA);
            PG8_BAR; PG8_WAIT_L(0); PG8_MMA(1, 0, At, B0); PG8_BAR; PG8_SCHED;
            PG8_STAGE(PG8_SB(0, 1), b2 + hstep, voffB);
            PG8_WAIT_V(6); PG8_BAR; PG8_MMA(1, 1, At, B1); PG8_BAR;
            PG8_LDB(B0, 1, 0); PG8_SCHED; PG8_LDA(At, 1, 0); PG8_STAGE(PG8_SA(0, 1), a2 + hstep, voffA);
            PG8_WAIT_L(8); PG8_BAR; PG8_WAIT_L(0); PG8_MMA(0, 0, At, B0); PG8_BAR; PG8_SCHED;
            PG8_LDB(B1, 1, 1); PG8_STAGE(PG8_SB(1, 0), b3, voffB);
            PG8_BAR; PG8_WAIT_L(0); PG8_MMA(0, 1, At, B1); PG8_BAR;
            PG8_LDA(At, 1, 1); PG8_STAGE(PG8_SA(1, 0), a3, voffA);
            PG8_BAR; PG8_WAIT_L(0); PG8_MMA(1, 0, At, B0); PG8_BAR; PG8_SCHED;
            PG8_STAGE(PG8_SB(1, 1), b3 + hstep, voffB);
            PG8_WAIT_V(6); PG8_BAR; PG8_MMA(1, 1, At, B1); PG8_BAR;
            }
        }
        if constexpr (ALIGN_EPI) { if (wr == 0) PG8_BAR; }
        if constexpr (!Epi::AFTER_DRAIN) { E(acc, cur, wr, wc, fr, fq); S.done(cur); }
        if (!has_next) break;
#pragma unroll
        for (int a = 0; a < 2; ++a)
#pragma unroll
            for (int b = 0; b < 2; ++b)
#pragma unroll
                for (int m = 0; m < 4; ++m)
#pragma unroll
                    for (int n = 0; n < 2; ++n) acc[a][b][m][n] = (f32x4){0.f, 0.f, 0.f, 0.f};
        cur = nxt; cA = nA; cB = nB; ++ui;
        if constexpr (ALIGN_EPI) { if (wr == 1) PG8_BAR; }
    }
    PG8_WAIT_V(0);
    if constexpr (!ALIGN_EPI) { if (wr == 0) PG8_BAR; }
    PG8_BAR;
    if constexpr (Epi::AFTER_DRAIN) { E.fused(acc, cur, wr, wc, fr, fq, lds, wid, lane); S.done(cur); }
#undef PG8_SA
#undef PG8_SB
#undef PG8_STAGE
#undef PG8_LDA
#undef PG8_LDB
#undef PG8_MMA
#undef PG8_WAIT_V
#undef PG8_WAIT_L
#undef PG8_BAR
#undef PG8_SCHED
}
}

#ifndef PG8_SP2
#define PG8_SP2 true
#endif
#ifndef PG8_ALIGN
#define PG8_ALIGN true
#endif
#define GAS __attribute__((address_space(1)))
#define LAS __attribute__((address_space(3)))
typedef unsigned short bf16;
typedef unsigned v4u __attribute__((ext_vector_type(4)));
typedef float f32x4 __attribute__((ext_vector_type(4)));
typedef short bf16x8 __attribute__((ext_vector_type(8)));
typedef GAS unsigned gu32;
typedef GAS unsigned long long gu64;
#define RLX_AGENT __ATOMIC_RELAXED, __HIP_MEMORY_SCOPE_AGENT
#define LDS_WAIT() asm volatile("s_waitcnt lgkmcnt(0)" ::: "memory")
#define VM_WAIT() asm volatile("s_waitcnt vmcnt(0)" ::: "memory")
__device__ __forceinline__ unsigned long long rt() { return __builtin_amdgcn_s_memrealtime(); }
__device__ __forceinline__ unsigned f2bf(float f) { unsigned u = __builtin_bit_cast(unsigned, f); return (u + 0x7fffu + ((u >> 16) & 1u)) >> 16; }
__device__ __forceinline__ unsigned pk2(float lo, float hi) { return f2bf(lo) | (f2bf(hi) << 16); }

#define XB_TMO      128
#define XB_XCNT(j)  (256  + 64 * (j))
#define XB_XSUB(j)  (1280 + 64 * (j))
#define XB_XGEN(j)  (2304 + 64 * (j))
#define XB_TOP      3328
#define XB_TOPGEN   3392
#define XCD_BAR_WORDS 3456
#define XB_SPIN_CAP (1u << 22)

__device__ __forceinline__ unsigned xb_ld(unsigned* p)              { return __hip_atomic_load(p, __ATOMIC_RELAXED, __HIP_MEMORY_SCOPE_AGENT); }
__device__ __forceinline__ unsigned xb_add(unsigned* p, unsigned v) { return __hip_atomic_fetch_add(p, v, __ATOMIC_RELAXED, __HIP_MEMORY_SCOPE_AGENT); }
__device__ __forceinline__ unsigned xb_xcc_id() { return (unsigned)__builtin_amdgcn_s_getreg((3 << 11) | 20) & 0xFu; }
#define XB_SPIN(cond, bar) do { unsigned _sp = 0; while (cond) { __builtin_amdgcn_s_sleep(1); \
    if ((++_sp & 255u) == 0u) { if (xb_ld(&(bar)[XB_TMO])) break; if (_sp > XB_SPIN_CAP) { atomicAdd(&(bar)[XB_TMO], 1u); break; } } } } while (0)

struct XcdBarrier {
    unsigned* bar; unsigned x;
    volatile LAS unsigned* st;
};

__device__ __forceinline__ XcdBarrier xcd_barrier_post(unsigned* bar, volatile LAS unsigned* st) {
    XcdBarrier b; b.bar = bar; b.x = xb_xcc_id(); b.st = st;
    if (threadIdx.x == 0) (void)xb_add(&bar[XB_XCNT(b.x)], 1u);
    return b;
}
__device__ __forceinline__ void xcd_barrier_complete(unsigned* bar, unsigned x, unsigned& nloc, unsigned& nx) {
    const unsigned G = gridDim.x * gridDim.y * gridDim.z;
    unsigned sum, cnt, mine, sp = 0u;
    for (;;) {
        sum = 0u; cnt = 0u; mine = 0u;
#pragma unroll
        for (unsigned j = 0; j < 16; ++j) { const unsigned c = xb_ld(&bar[XB_XCNT(j)]); sum += c; cnt += (c > 0u) ? 1u : 0u; mine = (j == x) ? c : mine; }
        if (sum == G) break;
        __builtin_amdgcn_s_sleep(1);
        if ((++sp & 255u) == 0u) { if (xb_ld(&bar[XB_TMO])) break; if (sp > XB_SPIN_CAP) { atomicAdd(&bar[XB_TMO], 1u); break; } }
    }
    nloc = mine > 0u ? mine : 1u; nx = cnt > 0u ? cnt : 1u;
}

__device__ __forceinline__ void xcd_barrier(const XcdBarrier& b) {
    asm volatile("s_waitcnt vmcnt(0)" ::: "memory");
    __syncthreads();
    if (threadIdx.x == 0) {
        unsigned* bar = b.bar;
        __builtin_amdgcn_s_waitcnt(0);
        unsigned nloc = b.st[0], nx = b.st[1];
        if (nloc == 0u) { xcd_barrier_complete(bar, b.x, nloc, nx); b.st[0] = nloc; b.st[1] = nx; }
        const unsigned old = xb_add(&bar[XB_XSUB(b.x)], 1u);
        const unsigned gen = old / nloc;
        if (old + 1u == (gen + 1u) * nloc) {
            __builtin_amdgcn_fence(__ATOMIC_RELEASE, "agent");
            asm volatile("s_waitcnt vmcnt(0)" ::: "memory");
            const unsigned og = xb_add(&bar[XB_TOP], 1u);
            const unsigned tg = og / nx;
            if (og + 1u == (tg + 1u) * nx) xb_add(&bar[XB_TOPGEN], 1u);
            else XB_SPIN(xb_ld(&bar[XB_TOPGEN]) == tg, bar);
            __builtin_amdgcn_fence(__ATOMIC_ACQUIRE, "agent");
            xb_add(&bar[XB_XGEN(b.x)], 1u);
            asm volatile("s_waitcnt vmcnt(0)" ::: "memory");
        } else {
            XB_SPIN(xb_ld(&bar[XB_XGEN(b.x)]) == gen, bar);
            __builtin_amdgcn_fence(__ATOMIC_ACQUIRE, "agent");
            asm volatile("s_waitcnt vmcnt(0)" ::: "memory");
        }
    }
    __syncthreads();
}
constexpr int NWAVES = 8;
constexpr int BATCH = 4, T = 4096, D = 1024, M = BATCH * T;
constexpr int RW_W = 512, RW_COLS = 2304, HG_COLS = 2560, IN_COLS = 4864;
constexpr size_t MiB = 1u << 20;
constexpr size_t WS_CTL = 0, CTL_ZERO_BYTES = 1 * MiB;
constexpr size_t WS_P = 1 * MiB;
constexpr size_t WS_XN = 153 * MiB;
constexpr size_t WS_WIN = 185 * MiB;
constexpr size_t WS_WOUT = 249 * MiB;
constexpr size_t WS_BON = 251 * MiB;
constexpr size_t WS_W2T = 252 * MiB;
constexpr size_t WS_A2T = 252 * MiB + 131072;
constexpr size_t WS_OHG = 153 * MiB;
constexpr size_t WS_Q = 185 * MiB;
constexpr size_t WS_Y = 217 * MiB;
constexpr size_t WS_END = 256 * MiB;
constexpr int CW_TMO = 0, CW_CODE = 1, CW_BAR = 4096;
constexpr int RING_OFF = 0, RING_BYTES = 143360;
constexpr int LDSCTL_OFF = RING_BYTES, MISC_OFF = LDSCTL_OFF + 320;
constexpr int LDS_BYTES = 147456;
__device__ __forceinline__ float wave_sum(float v) {
#pragma unroll
    for (int o = 1; o < 64; o <<= 1) v += __shfl_xor(v, o);
    return v;
}
__device__ __forceinline__ void p0_transpose_item(const float* W, int K, int N, bf16* WT, LAS float* scr, int item, int lane) {
    const int nblk = N / 32, kb = item / nblk, nb = item % nblk, k0 = 64 * kb, n0 = 32 * nb;
#pragma unroll 8
    for (int i = 0; i < 32; ++i) { const int kk = 2 * i + (lane >> 5); scr[kk * 33 + (lane & 31)] = W[(size_t)(k0 + kk) * N + n0 + (lane & 31)]; }
    LDS_WAIT(); asm volatile("" ::: "memory");
    const int c = lane & 7;
#pragma unroll
    for (int j = 0; j < 4; ++j) { const int n = (lane >> 3) + 8 * j; const LAS float* s = scr + (8 * c) * 33 + n;
        v4u o; o.x = pk2(s[0 * 33], s[1 * 33]); o.y = pk2(s[2 * 33], s[3 * 33]); o.z = pk2(s[4 * 33], s[5 * 33]); o.w = pk2(s[6 * 33], s[7 * 33]);
        *(GAS v4u*)(WT + (size_t)(n0 + n) * K + k0 + 8 * c) = o; }
    LDS_WAIT(); asm volatile("" ::: "memory");
}
__device__ __forceinline__ void rms_row_to_bf16(const float* xrow, const float* g, bf16* orow, int lane) {
    const GAS f32x4* xr = (const GAS f32x4*)xrow + lane;
    const GAS f32x4* gr = (const GAS f32x4*)g + lane;
    f32x4 v[4]; float s = 0.f;
#pragma unroll
    for (int j = 0; j < 4; ++j) { v[j] = xr[64 * j]; s += (v[j].x * v[j].x + v[j].y * v[j].y) + (v[j].z * v[j].z + v[j].w * v[j].w); }
    const float rstd = 1.f / sqrtf(wave_sum(s) * (1.f / D) + 1e-6f);
    GAS unsigned long long* o8 = (GAS unsigned long long*)orow + lane;
#pragma unroll
    for (int j = 0; j < 4; ++j) { const f32x4 gv = gr[64 * j];
        o8[64 * j] = (unsigned long long)pk2(v[j].x * rstd * gv.x, v[j].y * rstd * gv.y) | ((unsigned long long)pk2(v[j].z * rstd * gv.z, v[j].w * rstd * gv.w) << 32); }
}

__device__ __forceinline__ float bfu(bf16 b) { return __uint_as_float(((unsigned)b) << 16); }
__device__ __forceinline__ float shifted_tok(const bf16* __restrict__ p, int b, int t, int c, float mup, float mun) {
    const size_t row = (size_t)b * T + t;
    const float cur = bfu(p[row * IN_COLS + c]);
    const float prv = t > 0 ? bfu(p[(row - 1) * IN_COLS + c]) : 0.f;
    const float nxt = t < T - 1 ? bfu(p[(row + 1) * IN_COLS + c]) : 0.f;
    return cur + mup * (prv - cur) + mun * (nxt - cur);
}
__device__ __forceinline__ float sigmoidf_(float v) { return 1.0f / (1.0f + __expf(-v)); }

__device__ __forceinline__ void mix_row(const bf16* __restrict__ p, const float* const* in, const bf16* __restrict__ Yarr, const float* __restrict__ bonus, const bf16* __restrict__ o_hg, bf16* __restrict__ ymix, int row, int lane) {
    const float* mu_prev = in[3]; const float* mu_next = in[4]; const float* ln_w = in[12]; const float* ln_b = in[13]; const float* norm_g = in[15];
    const int b = row / T, t = row % T;
#pragma unroll 2
    for (int i = 0; i < 8; ++i) {
        const int c = i * 64 + lane;
        const size_t itf = ((size_t)((0 * 4 + b) * 8 + i)) * 64 + (t >> 6), itb = ((size_t)((1 * 4 + b) * 8 + i)) * 64 + (63 - (t >> 6));
        const float y = bfu(Yarr[itf * 4096 + (t & 63) * 64 + lane]) + bfu(Yarr[itb * 4096 + (63 - (t & 63)) * 64 + lane]);
        const float mu = wave_sum(y) * (1.0f / 64.0f);
        const float dlt = y - mu;
        const float var = wave_sum(dlt * dlt) * (1.0f / 64.0f);
        float yn = dlt * (1.0f / sqrtf(var + 64e-5f)) * ln_w[c] + ln_b[c];
        const float vs = shifted_tok(p, b, t, 1024 + c, mu_prev[1024 + c], mu_next[1024 + c]);
        const float gs = shifted_tok(p, b, t, 1536 + c, mu_prev[1536 + c], mu_next[1536 + c]);
        const float bo = bonus[(size_t)row * 8 + i] + bonus[((size_t)M + row) * 8 + i];
        yn += bo * vs;
        ymix[(size_t)row * 1024 + c] = (bf16)f2bf(yn * gs * sigmoidf_(gs));
    }
#pragma unroll
    for (int hh = 0; hh < 4; ++hh) {
        const int c0 = hh * 128 + lane, c1 = c0 + 64;
        const float o0 = bfu(o_hg[(size_t)row * 512 + c0]) + bfu(o_hg[((size_t)M + row) * 512 + c0]);
        const float o1 = bfu(o_hg[(size_t)row * 512 + c1]) + bfu(o_hg[((size_t)M + row) * 512 + c1]);
        const float rstd = 1.0f / sqrtf(wave_sum(o0 * o0 + o1 * o1) * (1.0f / 128.0f) + 1e-6f);
        const float g0 = bfu(p[(size_t)row * IN_COLS + RW_COLS + 2048 + c0]), g1 = bfu(p[(size_t)row * IN_COLS + RW_COLS + 2048 + c1]);
        ymix[(size_t)row * 1024 + 512 + c0] = (bf16)f2bf(o0 * rstd * norm_g[lane] * g0);
        ymix[(size_t)row * 1024 + 512 + c1] = (bf16)f2bf(o1 * rstd * norm_g[64 + lane] * g1);
    }
}
__device__ __forceinline__ void post_row(const float* xrow, const float* yrow, const float* g, float* orow, int lane) {
    const GAS f32x4* yr = (const GAS f32x4*)yrow + lane; const GAS f32x4* xr = (const GAS f32x4*)xrow + lane; const GAS f32x4* gr = (const GAS f32x4*)g + lane;
    f32x4 v[4]; float s = 0.f;
#pragma unroll
    for (int j = 0; j < 4; ++j) { v[j] = yr[64 * j]; s += (v[j].x * v[j].x + v[j].y * v[j].y) + (v[j].z * v[j].z + v[j].w * v[j].w); }
    const float rstd = 1.f / sqrtf(wave_sum(s) * (1.f / D) + 1e-6f);
    GAS f32x4* o4 = (GAS f32x4*)orow + lane;
#pragma unroll
    for (int j = 0; j < 4; ++j) o4[64 * j] = xr[64 * j] + v[j] * rstd * gr[64 * j];
}
typedef unsigned v2u __attribute__((ext_vector_type(2)));
__device__ __forceinline__ f32x4 mfma16(bf16x8 a, bf16x8 b, f32x4 c) { return __builtin_amdgcn_mfma_f32_16x16x32_bf16(a, b, c, 0, 0, 0); }
constexpr int MS = 144;
constexpr int MB = 64 * MS;
constexpr int A_LWO = 0, A_LAO = 16384;
constexpr int A_LQ = 0, A_PKK = 16384;
constexpr int A_TW = 32768, A_AD = 32768 + MB;
constexpr int A_WP = 32768;
constexpr int A_KKT = 51200, A_RT = A_KKT + MB, A_KH = A_RT + MB, A_BH = A_KH + MB, A_KHT = A_BH + MB, A_BHT = A_KHT + MB, A_VT = A_BHT + MB;
constexpr int A_XT = A_KH;
constexpr int A_PRB = A_VT + MB, A_PRK = A_PRB + MB;
constexpr int A_EC = A_PRK + MB, A_SEG = A_EC + 256, A_END = A_SEG + 2048;
static_assert(A_VT + MB == 115712 && A_END <= 143360, "2a LDS map");
constexpr int WPS = 72;

__device__ __forceinline__ bf16x8 ldsfrag(LAS const unsigned char* base, int row0, int k0, int lane) {
    return *(const LAS bf16x8*)(base + (row0 + (lane & 15)) * MS + (k0 + 8 * (lane >> 4)) * 2);
}
template <int CTRL> __device__ __forceinline__ float dppx(float x) { return __int_as_float(__builtin_amdgcn_update_dpp(0, __float_as_int(x), CTRL, 0xF, 0xF, true)); }
__device__ __forceinline__ float wsum(float x) {
    x += dppx<0xB1>(x); x += dppx<0x4E>(x); x += dppx<0x141>(x); x += dppx<0x140>(x);
    const int xi = __float_as_int(x);
    const float a = __int_as_float(__builtin_amdgcn_readlane(xi, 0)), b = __int_as_float(__builtin_amdgcn_readlane(xi, 16)), c = __int_as_float(__builtin_amdgcn_readlane(xi, 32)), d = __int_as_float(__builtin_amdgcn_readlane(xi, 48));
    return (a + b) + (c + d);
}
__device__ __forceinline__ float quad_sum(float x) { x += dppx<0xB1>(x); x += dppx<0x4E>(x); return x; }
typedef __bf16 bf16x2_t __attribute__((ext_vector_type(2)));
typedef float f32x2_t __attribute__((ext_vector_type(2)));
__device__ __forceinline__ unsigned pkbf(float lo, float hi) { f32x2_t v = {lo, hi}; bf16x2_t b = __builtin_convertvector(v, bf16x2_t); return __builtin_bit_cast(unsigned, b); }
__device__ __forceinline__ bf16 bf1(float v) { return (bf16)(pkbf(v, 0.f) & 0xffffu); }

__device__ __forceinline__ void rw2a_dir(int d, LAS unsigned char* lds, const bf16* __restrict__ P, const float* const* in, const bf16* __restrict__ W2T, const bf16* __restrict__ A2T,
                                         bf16* __restrict__ Marr, bf16* __restrict__ Narr, bf16* __restrict__ Qarr, bf16* __restrict__ Yarr, float* __restrict__ BON,
                                         int b, int h, int c, int tid, int lane, int wave) {
    const float* mu_prev = in[3]; const float* mu_next = in[4];
    const int g = lane >> 4, l15 = lane & 15;
    const size_t rowbase = (size_t)b * T + (size_t)c * 64;
    {
        const int cs = d ? 63 - c : c;
        const size_t item = ((size_t)((d * 4 + b) * 8 + h)) * 64 + cs;
        {
            const int tau = tid >> 3, cg = tid & 7;
            const int t = c * 64 + tau;
#pragma unroll
            for (int arr = 0; arr < 2; ++arr) {
                const int col0 = (arr == 0 ? 2048 : 2176) + d * 64 + 8 * cg;
                const bf16* pr = P + (rowbase + tau) * IN_COLS + col0;
                const v4u cur = *(const v4u*)pr;
                v4u prv = (v4u){0u, 0u, 0u, 0u}, nxt = (v4u){0u, 0u, 0u, 0u};
                if (t > 0) prv = *(const v4u*)(pr - IN_COLS);
                if (t < T - 1) nxt = *(const v4u*)(pr + IN_COLS);
                const f32x4 mp0 = *(const f32x4*)(mu_prev + col0), mp1 = *(const f32x4*)(mu_prev + col0 + 4);
                const f32x4 mn0 = *(const f32x4*)(mu_next + col0), mn1 = *(const f32x4*)(mu_next + col0 + 4);
                float o[8];
#pragma unroll
                for (int e = 0; e < 8; ++e) {
                    const unsigned cw = cur[e >> 1], pw = prv[e >> 1], nw = nxt[e >> 1];
                    const float cv = __uint_as_float((e & 1) ? (cw & 0xffff0000u) : (cw << 16));
                    const float pv = __uint_as_float((e & 1) ? (pw & 0xffff0000u) : (pw << 16));
                    const float nv = __uint_as_float((e & 1) ? (nw & 0xffff0000u) : (nw << 16));
                    const float mp = e < 4 ? mp0[e & 3] : mp1[e & 3], mn = e < 4 ? mn0[e & 3] : mn1[e & 3];
                    float sv = cv + mp * (pv - cv) + mn * (nv - cv);
                    if (arr == 0) { const float ex = __expf(2.0f * sv); sv = 1.0f - 2.0f * __builtin_amdgcn_rcpf(ex + 1.0f); }
                    o[e] = sv;
                }
                v4u w; w.x = pkbf(o[0], o[1]); w.y = pkbf(o[2], o[3]); w.z = pkbf(o[4], o[5]); w.w = pkbf(o[6], o[7]);
                *(LAS v4u*)(lds + (arr == 0 ? A_TW : A_AD) + tau * MS + cg * 16) = w;
            }
        }
        const int j = tid & 63, seg = tid >> 6;
        const int ch = h * 64 + j;
        unsigned short raw[3][10];
#pragma unroll
        for (int a3 = 0; a3 < 3; ++a3)
#pragma unroll
            for (int rr = 0; rr < 10; ++rr) {
                const int tau = d ? (64 - 8 * seg - rr) : (8 * seg - 1 + rr); const int t = c * 64 + tau;
                raw[a3][rr] = (t >= 0 && t < T) ? P[(size_t)((long)rowbase + tau) * IN_COLS + a3 * 512 + ch] : (unsigned short)0;
            }
        __syncthreads();
        {
            const int p = wave >> 2, tt = wave & 3;
            const bf16* WT = (p == 0 ? W2T : A2T) + ((size_t)d * 512 + h * 64) * 64;
            const bf16x8 a0 = ldsfrag(lds + (p == 0 ? A_TW : A_AD), 16 * tt, 0, lane), a1 = ldsfrag(lds + (p == 0 ? A_TW : A_AD), 16 * tt, 32, lane);
#pragma unroll
            for (int jt = 0; jt < 4; ++jt) {
                const bf16* bp = WT + (size_t)(16 * jt + l15) * 64 + 8 * g;
                const bf16x8 b0 = *(const bf16x8*)bp, b1 = *(const bf16x8*)(bp + 32);
                f32x4 acc = (f32x4){0.f, 0.f, 0.f, 0.f};
                acc = mfma16(a0, b0, acc); acc = mfma16(a1, b1, acc);
                LAS float* o = (LAS float*)(lds + (p == 0 ? A_LWO : A_LAO)) + (16 * tt + 4 * g) * 64 + 16 * jt + l15;
#pragma unroll
                for (int rg = 0; rg < 4; ++rg) o[rg * 64] = acc[rg];
            }
        }
        __syncthreads();
        float lw[8], cl[8];
        {
            const float w0c = in[5][d * 512 + ch];
            float run = 0.f;
#pragma unroll
            for (int i = 0; i < 8; ++i) {
                const int sg = 8 * seg + i, tau = d ? 63 - sg : sg;
                const float wr = w0c + ((const LAS float*)(lds + A_LWO))[tau * 64 + j];
                lw[i] = -0.87504921f * __builtin_amdgcn_rcpf(1.0f + __expf(-wr));
                run += lw[i]; cl[i] = run;
            }
            ((LAS float*)(lds + A_SEG))[seg * 64 + j] = run;
        }
        __syncthreads();
        float off = 0.f, ctot = 0.f;
#pragma unroll
        for (int s8 = 0; s8 < 8; ++s8) { const float v = ((const LAS float*)(lds + A_SEG))[s8 * 64 + j]; if (s8 < seg) off += v; ctot += v; }
        if (seg == 7) ((LAS float*)(lds + A_EC))[j] = __builtin_amdgcn_exp2f(ctot);
        {
            const float a0c = in[7][d * 512 + ch], kkc = in[9][ch], kac = in[10][ch], rkc = in[11][ch];
            const float mpr = mu_prev[ch], mnr = mu_next[ch], mpk = mu_prev[512 + ch], mnk = mu_next[512 + ch], mpv = mu_prev[1024 + ch], mnv = mu_next[1024 + ch];
            float kht[8], bht[8], vt[8];
#pragma unroll
            for (int i = 0; i < 8; ++i) {
                const int sg = 8 * seg + i, tau = d ? 63 - sg : sg;
                float sh[3];
#pragma unroll
                for (int a3 = 0; a3 < 3; ++a3) {
                    const float cv = __uint_as_float((unsigned)raw[a3][i + 1] << 16), lo_ = __uint_as_float((unsigned)raw[a3][i] << 16), hi_ = __uint_as_float((unsigned)raw[a3][i + 2] << 16);
                    const float pv = d ? hi_ : lo_, nv = d ? lo_ : hi_;
                    const float mp = a3 == 0 ? mpr : (a3 == 1 ? mpk : mpv), mn = a3 == 0 ? mnr : (a3 == 1 ? mnk : mnv);
                    sh[a3] = cv + mp * (pv - cv) + mn * (nv - cv);
                }
                const float rs = sh[0], ks = sh[1], vs = sh[2];
                const float ar = a0c + ((const LAS float*)(lds + A_LAO))[tau * 64 + j];
                const float a = __builtin_amdgcn_rcpf(1.0f + __expf(-ar));
                float kkv = ks * kkc;
                const float n2 = wsum(kkv * kkv);
                kkv = kkv * __builtin_amdgcn_rsqf(fmaxf(n2, 1e-24f));
                const float kd = ks * (1.0f + (a - 1.0f) * kac);
                const float bb = kkv * a;
                const float bo = wsum(rs * kd * rkc);
                if (lane == 0) BON[((size_t)d * M + rowbase + tau) * 8 + h] = bo;
                const float cs_ = off + cl[i];
                const float E = __builtin_amdgcn_exp2f(cs_), Ep = __builtin_amdgcn_exp2f(cs_ - lw[i]), Ei = __builtin_amdgcn_exp2f(-cs_);
                const int o2 = sg * MS + 2 * j;
                *(LAS bf16*)(lds + A_KKT + o2) = bf1(kkv * Ep);
                *(LAS bf16*)(lds + A_RT + o2) = bf1(rs * E);
                const float khv = kd * Ei, bhv = bb * Ei;
                *(LAS bf16*)(lds + A_KH + o2) = bf1(khv);
                *(LAS bf16*)(lds + A_BH + o2) = bf1(bhv);
                kht[i] = khv; bht[i] = bhv; vt[i] = vs;
            }
            v4u w;
            w.x = pkbf(kht[0], kht[1]); w.y = pkbf(kht[2], kht[3]); w.z = pkbf(kht[4], kht[5]); w.w = pkbf(kht[6], kht[7]);
            *(LAS v4u*)(lds + A_KHT + j * MS + seg * 16) = w;
            w.x = pkbf(bht[0], bht[1]); w.y = pkbf(bht[2], bht[3]); w.z = pkbf(bht[4], bht[5]); w.w = pkbf(bht[6], bht[7]);
            *(LAS v4u*)(lds + A_BHT + j * MS + seg * 16) = w;
            w.x = pkbf(vt[0], vt[1]); w.y = pkbf(vt[2], vt[3]); w.z = pkbf(vt[4], vt[5]); w.w = pkbf(vt[6], vt[7]);
            *(LAS v4u*)(lds + A_VT + j * MS + seg * 16) = w;
        }
        __syncthreads();
        {
            const int p = wave >> 1;
            const int tside = (p < 2) ? A_KKT : A_RT, sside = (p == 0 || p == 2) ? A_BH : A_KH;
            const int pout = (p == 1) ? A_PKK : (p == 2 ? A_PRB : A_PRK);
#pragma unroll
            for (int q2 = 0; q2 < 2; ++q2) {
                const int tt = (wave & 1) ? (1 + q2) : (3 * q2);
                const bf16x8 t0 = ldsfrag(lds + tside, 16 * tt, 0, lane), t1 = ldsfrag(lds + tside, 16 * tt, 32, lane);
                for (int st = 0; st <= tt; ++st) {
                    const bf16x8 s0 = ldsfrag(lds + sside, 16 * st, 0, lane), s1 = ldsfrag(lds + sside, 16 * st, 32, lane);
                    f32x4 acc = (f32x4){0.f, 0.f, 0.f, 0.f};
                    if (p == 0) {
                        acc = mfma16(t0, s0, acc); acc = mfma16(t1, s1, acc);
                        const int s = 16 * st + l15;
#pragma unroll
                        for (int rg = 0; rg < 4; ++rg) { const int t = 16 * tt + 4 * g + rg;
                            ((LAS float*)(lds + A_LQ))[t * 64 + (s & 3) * 16 + (s >> 2)] = (s < t) ? acc[rg] : 0.f; }
                    } else {
                        acc = mfma16(s0, t0, acc); acc = mfma16(s1, t1, acc);
                        const int t = 16 * tt + l15, sb = 16 * st + 4 * g;
                        float m[4];
#pragma unroll
                        for (int rg = 0; rg < 4; ++rg) { const int s = sb + rg; const bool keep = (p == 1) ? (s < t) : (s <= t); m[rg] = keep ? acc[rg] : 0.f; }
                        v2u w; w.x = pkbf(m[0], m[1]); w.y = pkbf(m[2], m[3]);
                        *(LAS v2u*)(lds + pout + t * MS + sb * 2) = w;
                    }
                }
                if (p != 0 && (tt == 0 || tt == 2)) {
                    *(LAS v2u*)(lds + pout + (16 * tt + l15) * MS + (16 * (tt + 1) + 4 * g) * 2) = (v2u){0u, 0u};
                }
            }
        }
        __syncthreads();
        {
            const int tt = wave >> 1;
#pragma unroll
            for (int q2 = 0; q2 < 2; ++q2) {
                const int vtile = 2 * (wave & 1) + q2;
                f32x4 acc = (f32x4){0.f, 0.f, 0.f, 0.f};
                acc = mfma16(ldsfrag(lds + A_PKK, 16 * tt, 0, lane), ldsfrag(lds + A_VT, 16 * vtile, 0, lane), acc);
                if (tt >= 2) acc = mfma16(ldsfrag(lds + A_PKK, 16 * tt, 32, lane), ldsfrag(lds + A_VT, 16 * vtile, 32, lane), acc);
                LAS float* o = (LAS float*)(lds + A_WP) + (16 * tt + 4 * g) * WPS + 16 * vtile + l15;
#pragma unroll
                for (int rg = 0; rg < 4; ++rg) o[rg * WPS] = acc[rg];
            }
        }
        __syncthreads();
        float X[16];
        {
            const int col = tid >> 2, q = tid & 3;
            float R[16];
#pragma unroll
            for (int m = 0; m < 16; ++m) {
                const int t = 4 * m + q;
                R[m] = (col < 64) ? __uint_as_float((unsigned)(*(const LAS bf16*)(lds + A_KKT + t * MS + col * 2)) << 16)
                                  : ((const LAS float*)(lds + A_WP))[t * WPS + (col - 64)];
                X[m] = 0.f;
            }
            const LAS float* Lq = (const LAS float*)(lds + A_LQ) + q * 16;
#pragma unroll
            for (int t = 0; t < 64; ++t) {
                float part = ((t & 3) == q) ? R[t >> 2] : 0.f;
                const int nm = (t + 3) >> 2;
#pragma unroll
                for (int m4 = 0; m4 < (nm + 3) / 4; ++m4) {
                    const f32x4 lv = *(const LAS f32x4*)(Lq + t * 64 + 4 * m4);
#pragma unroll
                    for (int e = 0; e < 4; ++e) if (4 * m4 + e < nm) part -= lv[e] * X[4 * m4 + e];
                }
                const float tot = quad_sum(part);
                X[t >> 2] = ((t & 3) == q) ? tot : X[t >> 2];
            }
        }
        __syncthreads();
        {
            const int col = tid >> 2, q = tid & 3;
#pragma unroll
            for (int m = 0; m < 16; ++m) *(LAS bf16*)(lds + A_XT + col * MS + (4 * m + q) * 2) = bf1(-X[m]);
        }
        __syncthreads();
        {
            const float* ECp = nullptr; (void)ECp;
            bf16* Mo = Marr + item * 4096; bf16* No = Narr + item * 4096; bf16* Qo = Qarr + item * 4096; bf16* Yo = Yarr + item * 4096;
#pragma unroll
            for (int q2 = 0; q2 < 2; ++q2) {
                const int e = 2 * wave + q2, ra = e >> 2, cb = e & 3;
                {
                    f32x4 acc = (f32x4){0.f, 0.f, 0.f, 0.f};
                    acc = mfma16(ldsfrag(lds + A_XT, 16 * ra, 0, lane), ldsfrag(lds + A_PRB, 16 * cb, 0, lane), acc);
                    if (cb >= 2) acc = mfma16(ldsfrag(lds + A_XT, 16 * ra, 32, lane), ldsfrag(lds + A_PRB, 16 * cb, 32, lane), acc);
                    const int t = 16 * cb + l15, jb = 16 * ra + 4 * g;
                    const v2u rw = *(const LAS v2u*)(lds + A_RT + t * MS + jb * 2);
                    const float r0 = __uint_as_float(rw.x << 16), r1 = __uint_as_float(rw.x & 0xffff0000u), r2 = __uint_as_float(rw.y << 16), r3 = __uint_as_float(rw.y & 0xffff0000u);
                    v2u w; w.x = pkbf(r0 + acc[0], r1 + acc[1]); w.y = pkbf(r2 + acc[2], r3 + acc[3]);
                    *(v2u*)(Qo + t * 64 + jb) = w;
                }
                {
                    f32x4 acc = (f32x4){0.f, 0.f, 0.f, 0.f};
                    acc = mfma16(ldsfrag(lds + A_VT, 16 * ra, 0, lane), ldsfrag(lds + A_PRK, 16 * cb, 0, lane), acc);
                    acc = mfma16(ldsfrag(lds + A_XT, 64 + 16 * ra, 0, lane), ldsfrag(lds + A_PRB, 16 * cb, 0, lane), acc);
                    if (cb >= 2) {
                        acc = mfma16(ldsfrag(lds + A_VT, 16 * ra, 32, lane), ldsfrag(lds + A_PRK, 16 * cb, 32, lane), acc);
                        acc = mfma16(ldsfrag(lds + A_XT, 64 + 16 * ra, 32, lane), ldsfrag(lds + A_PRB, 16 * cb, 32, lane), acc);
                    }
                    const int t = 16 * cb + l15, vb = 16 * ra + 4 * g;
                    v2u w; w.x = pkbf(acc[0], acc[1]); w.y = pkbf(acc[2], acc[3]);
                    *(v2u*)(Yo + t * 64 + vb) = w;
                }
                {
                    f32x4 acc = (f32x4){0.f, 0.f, 0.f, 0.f};
                    acc = mfma16(ldsfrag(lds + A_XT, 16 * ra, 0, lane), ldsfrag(lds + A_BHT, 16 * cb, 0, lane), acc);
                    acc = mfma16(ldsfrag(lds + A_XT, 16 * ra, 32, lane), ldsfrag(lds + A_BHT, 16 * cb, 32, lane), acc);
                    const int jj = 16 * cb + l15, jpb = 16 * ra + 4 * g;
                    const float ec = ((const LAS float*)(lds + A_EC))[jj];
                    float m[4];
#pragma unroll
                    for (int rg = 0; rg < 4; ++rg) m[rg] = ec * (((jpb + rg) == jj ? 1.0f : 0.0f) + acc[rg]);
                    v2u w; w.x = pkbf(m[0], m[1]); w.y = pkbf(m[2], m[3]);
                    *(v2u*)(Mo + jj * 64 + jpb) = w;
                }
                {
                    f32x4 acc = (f32x4){0.f, 0.f, 0.f, 0.f};
#pragma unroll
                    for (int ks = 0; ks < 2; ++ks) {
                        acc = mfma16(ldsfrag(lds + A_KHT, 16 * ra, 32 * ks, lane), ldsfrag(lds + A_VT, 16 * cb, 32 * ks, lane), acc);
                        acc = mfma16(ldsfrag(lds + A_BHT, 16 * ra, 32 * ks, lane), ldsfrag(lds + A_XT, 64 + 16 * cb, 32 * ks, lane), acc);
                    }
                    const int v = 16 * cb + l15, jb = 16 * ra + 4 * g;
                    const f32x4 ec = *(const LAS f32x4*)((const LAS float*)(lds + A_EC) + jb);
                    v2u w; w.x = pkbf(ec[0] * acc[0], ec[1] * acc[1]); w.y = pkbf(ec[2] * acc[2], ec[3] * acc[3]);
                    *(v2u*)(No + v * 64 + jb) = w;
                }
            }
        }
        __syncthreads();
    }
}
__device__ __forceinline__ void rw2a_item(LAS unsigned char* lds, const bf16* __restrict__ P, const float* const* in, const bf16* __restrict__ W2T, const bf16* __restrict__ A2T,
                                          bf16* __restrict__ Marr, bf16* __restrict__ Narr, bf16* __restrict__ Qarr, bf16* __restrict__ Yarr, float* __restrict__ BON,
                                          int b, int h, int c, int tid, int lane, int wave) {
#pragma unroll 1
    for (int d = 0; d < 2; ++d) rw2a_dir(d, lds, P, in, W2T, A2T, Marr, Narr, Qarr, Yarr, BON, b, h, c, tid, lane, wave);
}

__device__ __forceinline__ void rw2b_seq(LAS unsigned char* lds, const bf16* __restrict__ Marr, const bf16* __restrict__ Narr, const bf16* __restrict__ Qarr, bf16* __restrict__ Yarr,
                                         int seq, int vh, int tid, int lane, int wave) {
    const int g = lane >> 4, l15 = lane & 15;
    const int vt = wave & 1, rt = wave >> 1;
    constexpr int HB = 32 * MS;
    for (int u = tid; u < 2 * HB / 4; u += NWAVES * 64) ((LAS unsigned*)lds)[u] = 0u;
    __syncthreads();
    const size_t it0 = (size_t)seq * 64;
    const int offQ = (16 * rt + l15) * 64 + 8 * g;
    const int offY = (16 * rt + l15) * 64 + 32 * vh + 16 * vt + 4 * g;
    const int offN = (32 * vh + 16 * vt + l15) * 64 + 16 * rt + 4 * g;
    bf16x8 q0 = *(const bf16x8*)(Qarr + it0 * 4096 + offQ), q1 = *(const bf16x8*)(Qarr + it0 * 4096 + offQ + 32);
    bf16x8 m0 = *(const bf16x8*)(Marr + it0 * 4096 + offQ), m1 = *(const bf16x8*)(Marr + it0 * 4096 + offQ + 32);
    v2u yl = *(const v2u*)(Yarr + it0 * 4096 + offY), nl = *(const v2u*)(Narr + it0 * 4096 + offN);
    int cur = 0;
#pragma unroll 1
    for (int cs = 0; cs < 64; ++cs) {
        const size_t itn = it0 + (cs < 63 ? cs + 1 : cs);
        const bf16x8 nq0 = *(const bf16x8*)(Qarr + itn * 4096 + offQ), nq1 = *(const bf16x8*)(Qarr + itn * 4096 + offQ + 32);
        const bf16x8 nm0 = *(const bf16x8*)(Marr + itn * 4096 + offQ), nm1 = *(const bf16x8*)(Marr + itn * 4096 + offQ + 32);
        const v2u nyl = *(const v2u*)(Yarr + itn * 4096 + offY), nnl = *(const v2u*)(Narr + itn * 4096 + offN);
        const LAS unsigned char* hb = lds + cur * HB;
        const bf16x8 h0 = ldsfrag(hb, 16 * vt, 0, lane), h1 = ldsfrag(hb, 16 * vt, 32, lane);
        f32x4 ya; ya[0] = __uint_as_float(yl.x << 16); ya[1] = __uint_as_float(yl.x & 0xffff0000u); ya[2] = __uint_as_float(yl.y << 16); ya[3] = __uint_as_float(yl.y & 0xffff0000u);
        ya = mfma16(h0, q0, ya); ya = mfma16(h1, q1, ya);
        f32x4 ha; ha[0] = __uint_as_float(nl.x << 16); ha[1] = __uint_as_float(nl.x & 0xffff0000u); ha[2] = __uint_as_float(nl.y << 16); ha[3] = __uint_as_float(nl.y & 0xffff0000u);
        ha = mfma16(m0, h0, ha); ha = mfma16(m1, h1, ha);
        { v2u w; w.x = pkbf(ya[0], ya[1]); w.y = pkbf(ya[2], ya[3]); *(v2u*)(Yarr + (it0 + cs) * 4096 + offY) = w; }
        { v2u w; w.x = pkbf(ha[0], ha[1]); w.y = pkbf(ha[2], ha[3]); *(LAS v2u*)(lds + (cur ^ 1) * HB + (16 * vt + l15) * MS + (16 * rt + 4 * g) * 2) = w; }
        __syncthreads();
        cur ^= 1; q0 = nq0; q1 = nq1; m0 = nm0; m1 = nm1; yl = nyl; nl = nnl;
    }
}
constexpr int HS = 272;
constexpr int H_QT = 0, H_KT = 17408, H_KTT = 34816, H_VT = 53248, H_P = 57856, H_ST = 67072, H_G = 84480, H_SEG = 84992, H_END = 87040;
__device__ __forceinline__ bf16x8 ldsfrag_s(LAS const unsigned char* base, int row0, int k0, int lane, int stride) {
    return *(const LAS bf16x8*)(base + (row0 + (lane & 15)) * stride + (k0 + 8 * (lane >> 4)) * 2);
}
__device__ __forceinline__ void hg_seq(LAS unsigned char* lds, const bf16* __restrict__ P, bf16* __restrict__ OHG, int seq, int sl, int tid, int lane, int wave) {
    const int g = lane >> 4, l15 = lane & 15;
    const int h = seq & 3, b = (seq >> 2) & 3, d = seq >> 4;
    for (int u = tid; u < 2 * 8704 / 4; u += NWAVES * 64) ((LAS unsigned*)(lds + H_ST))[u] = 0u;
    const int ek = tid & 127, eseg = tid >> 7;
    const int vv = tid & 31, vgrp = tid >> 5;
    const bf16* pq = P + RW_COLS + h * 128 + ek;
    const bf16* pk = P + RW_COLS + 512 + d * 512 + h * 128 + ek;
    const bf16* pv = P + RW_COLS + 1536 + h * 128 + 32 * sl + vv;
    f32x4 S0 = (f32x4){0.f, 0.f, 0.f, 0.f}, S1 = (f32x4){0.f, 0.f, 0.f, 0.f};
    unsigned short kraw[16], qraw[16], vraw[4];
    {
        const size_t rb = (size_t)b * T + (size_t)(d ? 63 : 0) * 64;
#pragma unroll
        for (int i = 0; i < 16; ++i) { const int sg = 16 * eseg + i, tau = d ? 63 - sg : sg; kraw[i] = pk[(rb + tau) * IN_COLS]; qraw[i] = pq[(rb + tau) * IN_COLS]; }
#pragma unroll
        for (int i = 0; i < 4; ++i) { const int sg = 4 * vgrp + i, tau = d ? 63 - sg : sg; vraw[i] = pv[(rb + tau) * IN_COLS]; }
    }
    __syncthreads();
    int cur = 0;
#pragma unroll 1
    for (int cs = 0; cs < 64; ++cs) {
        const int cn = d ? 63 - cs : cs;
        const size_t rowbase = (size_t)b * T + (size_t)cn * 64;
        float Eseg[16], kv[16];
        {
            float run = 1.f;
#pragma unroll
            for (int i = 0; i < 16; ++i) { kv[i] = __uint_as_float((unsigned)kraw[i] << 16); run *= (1.0f - kv[i]); Eseg[i] = run; }
            ((LAS float*)(lds + H_SEG))[eseg * 128 + ek] = run;
            v2u w; w.x = (unsigned)vraw[0] | ((unsigned)vraw[1] << 16); w.y = (unsigned)vraw[2] | ((unsigned)vraw[3] << 16);
            *(LAS v2u*)(lds + H_VT + vv * MS + vgrp * 8) = w;
        }
        __syncthreads();
        {
            float pre = 1.f;
#pragma unroll
            for (int s4 = 0; s4 < 3; ++s4) { const float v = ((const LAS float*)(lds + H_SEG))[s4 * 128 + ek]; if (s4 < eseg) pre *= v; }
            if (eseg == 3) ((LAS float*)(lds + H_G))[ek] = pre * Eseg[15];
            float ktt[16];
#pragma unroll
            for (int i = 0; i < 16; ++i) {
                const int sg = 16 * eseg + i;
                const float E = fmaxf(pre * Eseg[i], 1e-30f), Ei = __builtin_amdgcn_rcpf(E);
                const float qv = __uint_as_float((unsigned)qraw[i] << 16);
                const float kt = kv[i] * Ei;
                *(LAS bf16*)(lds + H_QT + sg * HS + 2 * ek) = bf1(qv * E);
                *(LAS bf16*)(lds + H_KT + sg * HS + 2 * ek) = bf1(kt);
                ktt[i] = kt;
            }
            v4u w;
            w.x = pkbf(ktt[0], ktt[1]); w.y = pkbf(ktt[2], ktt[3]); w.z = pkbf(ktt[4], ktt[5]); w.w = pkbf(ktt[6], ktt[7]);
            *(LAS v4u*)(lds + H_KTT + ek * MS + eseg * 32) = w;
            w.x = pkbf(ktt[8], ktt[9]); w.y = pkbf(ktt[10], ktt[11]); w.z = pkbf(ktt[12], ktt[13]); w.w = pkbf(ktt[14], ktt[15]);
            *(LAS v4u*)(lds + H_KTT + ek * MS + eseg * 32 + 16) = w;
        }
        if (cs < 63) {
            const int cn2 = d ? 62 - cs : cs + 1;
            const size_t rb = (size_t)b * T + (size_t)cn2 * 64;
#pragma unroll
            for (int i = 0; i < 16; ++i) { const int sg = 16 * eseg + i, tau = d ? 63 - sg : sg; kraw[i] = pk[(rb + tau) * IN_COLS]; qraw[i] = pq[(rb + tau) * IN_COLS]; }
#pragma unroll
            for (int i = 0; i < 4; ++i) { const int sg = 4 * vgrp + i, tau = d ? 63 - sg : sg; vraw[i] = pv[(rb + tau) * IN_COLS]; }
        }
        __syncthreads();
        {
#pragma unroll
            for (int q2 = 0; q2 < 2; ++q2) {
                const int id = wave + 8 * q2;
                if (id < 10) {
                    const int tt = (int)((0x3333222110ull >> (4 * id)) & 15ull), st = (int)((0x3210210100ull >> (4 * id)) & 15ull);
                    f32x4 acc = (f32x4){0.f, 0.f, 0.f, 0.f};
#pragma unroll
                    for (int kk = 0; kk < 4; ++kk) acc = mfma16(ldsfrag_s(lds + H_KT, 16 * st, 32 * kk, lane, HS), ldsfrag_s(lds + H_QT, 16 * tt, 32 * kk, lane, HS), acc);
                    const int t = 16 * tt + l15, sb = 16 * st + 4 * g;
                    float m[4];
#pragma unroll
                    for (int rg = 0; rg < 4; ++rg) m[rg] = (sb + rg <= t) ? acc[rg] : 0.f;
                    v2u w; w.x = pkbf(m[0], m[1]); w.y = pkbf(m[2], m[3]);
                    *(LAS v2u*)(lds + H_P + t * MS + sb * 2) = w;
                }
            }
            if (wave == 2 || wave == 3) { const int tt = (wave == 2) ? 0 : 2;
                *(LAS v2u*)(lds + H_P + (16 * tt + l15) * MS + (16 * (tt + 1) + 4 * g) * 2) = (v2u){0u, 0u}; }
        }
        __syncthreads();
        {
            const int vt = wave & 1, tt = wave >> 1;
            f32x4 acc = (f32x4){0.f, 0.f, 0.f, 0.f};
            acc = mfma16(ldsfrag_s(lds + H_VT, 16 * vt, 0, lane, MS), ldsfrag_s(lds + H_P, 16 * tt, 0, lane, MS), acc);
            if (tt >= 2) acc = mfma16(ldsfrag_s(lds + H_VT, 16 * vt, 32, lane, MS), ldsfrag_s(lds + H_P, 16 * tt, 32, lane, MS), acc);
#pragma unroll
            for (int kk = 0; kk < 4; ++kk) acc = mfma16(ldsfrag_s(lds + H_ST + cur * 8704, 16 * vt, 32 * kk, lane, HS), ldsfrag_s(lds + H_QT, 16 * tt, 32 * kk, lane, HS), acc);
            const int t = 16 * tt + l15, tau = d ? 63 - t : t;
            v2u w; w.x = pkbf(acc[0], acc[1]); w.y = pkbf(acc[2], acc[3]);
            *(v2u*)(OHG + ((size_t)d * M + rowbase + tau) * 512 + h * 128 + 32 * sl + 16 * vt + 4 * g) = w;
        }
        {
            const bf16x8 a0 = ldsfrag_s(lds + H_KTT, 16 * wave, 0, lane, MS), a1 = ldsfrag_s(lds + H_KTT, 16 * wave, 32, lane, MS);
            S0 = mfma16(a0, ldsfrag_s(lds + H_VT, 0, 0, lane, MS), S0); S0 = mfma16(a1, ldsfrag_s(lds + H_VT, 0, 32, lane, MS), S0);
            S1 = mfma16(a0, ldsfrag_s(lds + H_VT, 16, 0, lane, MS), S1); S1 = mfma16(a1, ldsfrag_s(lds + H_VT, 16, 32, lane, MS), S1);
            const f32x4 gv = *(const LAS f32x4*)((const LAS float*)(lds + H_G) + 16 * wave + 4 * g);
            S0 = S0 * gv; S1 = S1 * gv;
            LAS unsigned char* sn = lds + H_ST + (cur ^ 1) * 8704;
            v2u w; w.x = pkbf(S0[0], S0[1]); w.y = pkbf(S0[2], S0[3]);
            *(LAS v2u*)(sn + l15 * HS + (16 * wave + 4 * g) * 2) = w;
            w.x = pkbf(S1[0], S1[1]); w.y = pkbf(S1[2], S1[3]);
            *(LAS v2u*)(sn + (16 + l15) * HS + (16 * wave + 4 * g) * 2) = w;
        }
        __syncthreads();
        cur ^= 1;
    }
}
__device__ __forceinline__ void unpack8(const v4u w, float (&o)[8]) {
#pragma unroll
    for (int e = 0; e < 4; ++e) { o[2 * e] = __uint_as_float(w[e] << 16); o[2 * e + 1] = __uint_as_float(w[e] & 0xffff0000u); }
}
__device__ __forceinline__ float sum8lanes(float x) { x += dppx<0xB1>(x); x += dppx<0x4E>(x); x += dppx<0x141>(x); return x; }
__device__ __forceinline__ float sum16lanes(float x) { x = sum8lanes(x); x += dppx<0x140>(x); return x; }
__device__ __forceinline__ void ld8f(const float* p, float (&o)[8]) { const f32x4 a = *(const f32x4*)p, b = *(const f32x4*)(p + 4);
#pragma unroll
    for (int e = 0; e < 4; ++e) { o[e] = a[e]; o[4 + e] = b[e]; } }
__device__ __forceinline__ void mix_rows(const bf16* __restrict__ P, const float* const* in, const bf16* __restrict__ Yarr, const float* __restrict__ BON, const bf16* __restrict__ OHG, bf16* __restrict__ YMIX, int gw, int NGW, int lane) {
    const int c8 = 8 * lane, hd = lane >> 3, jo = c8 & 63;
    float mpv[8], mnv[8], mpg[8], mng[8], lnw[8], lnb[8], ng[8];
    ld8f(in[3] + 1024 + c8, mpv); ld8f(in[4] + 1024 + c8, mnv); ld8f(in[3] + 1536 + c8, mpg); ld8f(in[4] + 1536 + c8, mng);
    ld8f(in[12] + c8, lnw); ld8f(in[13] + c8, lnb); ld8f(in[15] + (c8 & 127), ng);
#pragma unroll 1
    for (int m = gw; m < M; m += NGW) {
        const int b = m >> 12, t = m & (T - 1);
        const size_t itf = ((size_t)((0 * 4 + b) * 8 + hd)) * 64 + (t >> 6), itb = ((size_t)((1 * 4 + b) * 8 + hd)) * 64 + (63 - (t >> 6));
        const v4u yfw = *(const v4u*)(Yarr + itf * 4096 + (t & 63) * 64 + jo), ybw = *(const v4u*)(Yarr + itb * 4096 + (63 - (t & 63)) * 64 + jo);
        const bf16* pr = P + (size_t)m * IN_COLS;
        const v4u vcw = *(const v4u*)(pr + 1024 + c8), gcw = *(const v4u*)(pr + 1536 + c8);
        v4u vpw = (v4u){0u, 0u, 0u, 0u}, vnw = vpw, gpw = vpw, gnw = vpw;
        if (t > 0) { vpw = *(const v4u*)(pr - IN_COLS + 1024 + c8); gpw = *(const v4u*)(pr - IN_COLS + 1536 + c8); }
        if (t < T - 1) { vnw = *(const v4u*)(pr + IN_COLS + 1024 + c8); gnw = *(const v4u*)(pr + IN_COLS + 1536 + c8); }
        const float bo = BON[(size_t)m * 8 + hd] + BON[((size_t)M + m) * 8 + hd];
        const v4u ofw = *(const v4u*)(OHG + (size_t)m * 512 + c8), obw = *(const v4u*)(OHG + ((size_t)M + m) * 512 + c8), ghw = *(const v4u*)(pr + RW_COLS + 2048 + c8);
        float yf[8], yb[8], y[8], vc[8], vp[8], vn[8], gc[8], gp[8], gn[8];
        unpack8(yfw, yf); unpack8(ybw, yb); unpack8(vcw, vc); unpack8(vpw, vp); unpack8(vnw, vn); unpack8(gcw, gc); unpack8(gpw, gp); unpack8(gnw, gn);
        float s = 0.f;
#pragma unroll
        for (int e = 0; e < 8; ++e) { y[e] = yf[e] + yb[e]; s += y[e]; }
        const float mu = sum8lanes(s) * (1.0f / 64.0f);
        float q = 0.f;
#pragma unroll
        for (int e = 0; e < 8; ++e) { y[e] -= mu; q += y[e] * y[e]; }
        const float rs = __builtin_amdgcn_rsqf(sum8lanes(q) * (1.0f / 64.0f) + 64e-5f);
        float o[8];
#pragma unroll
        for (int e = 0; e < 8; ++e) {
            const float vs = vc[e] + mpv[e] * (vp[e] - vc[e]) + mnv[e] * (vn[e] - vc[e]);
            const float gs = gc[e] + mpg[e] * (gp[e] - gc[e]) + mng[e] * (gn[e] - gc[e]);
            const float yn = y[e] * rs * lnw[e] + lnb[e] + bo * vs;
            o[e] = yn * gs * __builtin_amdgcn_rcpf(1.0f + __expf(-gs));
        }
        v4u w; w.x = pkbf(o[0], o[1]); w.y = pkbf(o[2], o[3]); w.z = pkbf(o[4], o[5]); w.w = pkbf(o[6], o[7]);
        *(v4u*)(YMIX + (size_t)m * 1024 + c8) = w;
        float of[8], ob[8], gh[8];
        unpack8(ofw, of); unpack8(obw, ob); unpack8(ghw, gh);
        float ss = 0.f;
#pragma unroll
        for (int e = 0; e < 8; ++e) { of[e] += ob[e]; ss += of[e] * of[e]; }
        const float rstd = __builtin_amdgcn_rsqf(sum16lanes(ss) * (1.0f / 128.0f) + 1e-6f);
#pragma unroll
        for (int e = 0; e < 8; ++e) o[e] = of[e] * rstd * ng[e] * gh[e];
        w.x = pkbf(o[0], o[1]); w.y = pkbf(o[2], o[3]); w.z = pkbf(o[4], o[5]); w.w = pkbf(o[6], o[7]);
        *(v4u*)(YMIX + (size_t)m * 1024 + 512 + c8) = w;
    }
}
struct Args { const float* in[18]; float* out; unsigned char* ws; int ph_lo, ph_hi; };
__global__ void __launch_bounds__(NWAVES * 64, 2) mega(Args args) {
    extern __shared__ __attribute__((aligned(16))) unsigned char lds_raw[];
    LAS unsigned char* lds = (LAS unsigned char*)lds_raw;
    volatile LAS unsigned* MISC = (volatile LAS unsigned*)(lds + MISC_OFF);
    const int tid = threadIdx.x, lane = tid & 63, wave = __builtin_amdgcn_readfirstlane(tid >> 6);
    const int G = gridDim.x;
    const int vcu = (G % 8 == 0) ? ((int)blockIdx.x % 8) * (G / 8) + (int)blockIdx.x / 8 : (int)blockIdx.x;
    unsigned char* ws = args.ws;
    gu32* ctl = (gu32*)(ws + WS_CTL);
    for (int u = tid; u < (LDS_BYTES - LDSCTL_OFF) / 4; u += NWAVES * 64) ((LAS unsigned*)(lds + LDSCTL_OFF))[u] = 0u;
    __syncthreads();
    XcdBarrier bar = xcd_barrier_post((unsigned*)(ctl + CW_BAR), MISC + 8);
    const int lo = args.ph_lo, hi = args.ph_hi;
#define IN(k) (lo <= (k) && (k) < hi)
#define BOTH(k) (IN(k) && IN((k) + 1))
    const float* x = args.in[0]; const float* pre_g = args.in[1]; const float* w_in = args.in[2]; const float* w_out = args.in[16];
    bf16* P = (bf16*)(ws + WS_P); bf16* XN = (bf16*)(ws + WS_XN); bf16* WIN_T = (bf16*)(ws + WS_WIN); bf16* WOUT_T = (bf16*)(ws + WS_WOUT); bf16* W2T = (bf16*)(ws + WS_W2T); bf16* A2T = (bf16*)(ws + WS_A2T);
    bf16* Marr = (bf16*)args.out; bf16* Narr = (bf16*)args.out + (size_t)16 * 1024 * 1024; bf16* Qarr = (bf16*)(ws + WS_Q); bf16* Yarr = (bf16*)(ws + WS_Y); bf16* OHG = (bf16*)(ws + WS_OHG);

    if (IN(0)) {
        LAS float* scr = (LAS float*)(lds + RING_OFF + wave * 16384);
        const int gw = vcu * NWAVES + wave, NGW = G * NWAVES;
        constexpr int I_IN = (D / 64) * (IN_COLS / 32), I_OUT = (D / 64) * (D / 32);
        for (int it = gw; it < I_IN + I_OUT; it += NGW) {
            if (it < I_IN) p0_transpose_item(w_in, D, IN_COLS, WIN_T, scr, it, lane);
            else p0_transpose_item(w_out, D, D, WOUT_T, scr, it - I_IN, lane);
        }
        for (int it = gw; it < 64; it += NGW) {
            const int which = it >> 5, dd = (it >> 4) & 1, sub = it & 15;
            p0_transpose_item(args.in[which ? 8 : 6] + (size_t)dd * 64 * 512, 64, 512, (which ? A2T : W2T) + (size_t)dd * 512 * 64, scr, sub, lane);
        }
        for (int m = gw; m < M; m += NGW) rms_row_to_bf16(x + (size_t)m * D, pre_g, XN + (size_t)m * D, lane);
        if (BOTH(0)) xcd_barrier(bar);
    }
    if (IN(1)) {
        pg8::Gemm g{XN, WIN_T, M, IN_COLS, D}; pg8::StaticOrder S; S.init(M, IN_COLS, G, (int)blockIdx.x);
        pg8::EpiP E{P, IN_COLS, args.in[14]};
        pg8::gemm_phase<pg8::EpiP, pg8::StaticOrder, PG8_ALIGN, PG8_SP2>(lds + RING_OFF, g, S, E);
        if (BOTH(1)) xcd_barrier(bar);
    }
    float* BON = (float*)(ws + WS_BON); bf16* YMIX = Qarr; float* Y = args.out;
    if (IN(2)) {
        for (int i = 0; i < 8; ++i) { const int wi = vcu * 8 + i; rw2a_item(lds, P, args.in, W2T, A2T, Marr, Narr, Qarr, Yarr, BON, wi >> 9, (wi >> 6) & 7, wi & 63, tid, lane, wave); }
        if (BOTH(2)) xcd_barrier(bar);
    }
    if (IN(3)) {
        if (vcu < 128) rw2b_seq(lds, Marr, Narr, Qarr, Yarr, vcu >> 1, vcu & 1, tid, lane, wave);
        else hg_seq(lds, P, OHG, (vcu - 128) >> 2, (vcu - 128) & 3, tid, lane, wave);
        if (BOTH(3)) xcd_barrier(bar);
    }
    if (IN(4)) {
        const int gw = vcu * NWAVES + wave, NGW = G * NWAVES;
        mix_rows(P, args.in, Yarr, BON, OHG, YMIX, gw, NGW, lane);
        if (BOTH(4)) xcd_barrier(bar);
    }
    if (IN(5)) {
        pg8::Gemm g{YMIX, WOUT_T, M, D, D}; pg8::StaticOrder S; S.init(M, D, G, (int)blockIdx.x);
        pg8::EpiF32 E{Y, D, nullptr};
        pg8::gemm_phase<pg8::EpiF32, pg8::StaticOrder, PG8_ALIGN, PG8_SP2>(lds + RING_OFF, g, S, E);
        if (BOTH(5)) xcd_barrier(bar);
    }
    if (IN(6)) {
        const int gw = vcu * NWAVES + wave, NGW = G * NWAVES;
        for (int m = gw; m < M; m += NGW) post_row(x + (size_t)m * D, Y + (size_t)m * D, args.in[17], args.out + (size_t)m * D, lane);
    }
#undef IN
#undef BOTH
}
extern "C" void kernel_launch(void* const* d_in, const int* in_sizes, int n_in, void* d_out, int out_size, void* d_ws, size_t ws_size, hipStream_t stream) {
    static int grid = 0;
    if (grid == 0) {
        int dev = 0, cus = 0;
        if (hipGetDevice(&dev) != hipSuccess || hipDeviceGetAttribute(&cus, hipDeviceAttributeMultiprocessorCount, dev) != hipSuccess) { fprintf(stderr, "kernel_launch: device query failed\n"); grid = -1; return; }
        if (hipFuncSetAttribute((const void*)mega, hipFuncAttributeMaxDynamicSharedMemorySize, LDS_BYTES) != hipSuccess) { fprintf(stderr, "kernel_launch: hipFuncSetAttribute failed\n"); grid = -1; return; }
        (void)hipGetLastError();
        grid = cus;
    }
    if (grid < 0) return;
    (void)hipMemsetAsync((char*)d_ws + WS_CTL, 0, CTL_ZERO_BYTES, stream);
    Args a{};
    for (int i = 0; i < 18; ++i) a.in[i] = (const float*)d_in[i];
    a.out = (float*)d_out; a.ws = (unsigned char*)d_ws; a.ph_lo = 0; a.ph_hi = 7;
    hipLaunchKernelGGL(mega, dim3(grid), dim3(NWAVES * 64), LDS_BYTES, stream, a);
}
```
